# Optimizing an MI355X kernel written in HIP

```python
import math
import jax
import jax.numpy as jnp
from jax import lax
import numpy as np

D_MODEL = 1024
BATCH = 8
SEQ = 2048
DEPTH = 4

GRID_W = 64
CTX_LEN = 256
N_EVEN = (DEPTH + 1) // 2
N_ODD = DEPTH // 2
N_MOD = 9
DEEPNORM_ALPHA = (2.0 * DEPTH) ** 0.25
DEEPNORM_BETA = (8.0 * DEPTH) ** -0.25
LN_EPS = 1e-5
RMS_EPS = 1e-6
MACARON_WEIGHT = 0.5
FFN_HIDDEN = ((8 * D_MODEL // 3 + 255) // 256) * 256

HYENA_WIDTH = D_MODEL // 2
HYENA_ORDER = 2
HYENA_FILTERS = HYENA_ORDER - 1
HYENA_PROJ = (HYENA_ORDER + 1) * HYENA_WIDTH
HYENA_BANDS = 16
HYENA_EMB = 1 + 2 * HYENA_BANDS
HYENA_FILTER_HIDDEN = 64
HYENA_FAST_DECAY = 0.3
HYENA_SLOW_DECAY = 1.5
HYENA_TARGET = 1e-2

GLA_WIDTH = D_MODEL - HYENA_WIDTH
GLA_HEADS = 4
GLA_DV = GLA_WIDTH // GLA_HEADS
GLA_DK = GLA_DV // 2
GLA_QK = GLA_HEADS * GLA_DK
GLA_RANK = 16
GLA_TAU = 16.0
GLA_CHUNK = 64
EVEN_SIZES = (HYENA_PROJ, GLA_QK, GLA_QK, GLA_WIDTH, GLA_WIDTH, GLA_RANK, GLA_RANK)
EVEN_IN = HYENA_PROJ + 2 * GLA_QK + 2 * GLA_WIDTH + 2 * GLA_RANK

ATTN_HEAD_DIM = 128
ATTN_Q_HEADS = D_MODEL // ATTN_HEAD_DIM
ATTN_KV_HEADS = 2
ATTN_GROUP = ATTN_Q_HEADS // ATTN_KV_HEADS
ATTN_BLOCK = 128
ATTN_Q_WIDTH = ATTN_Q_HEADS * ATTN_HEAD_DIM
ATTN_KV_WIDTH = ATTN_KV_HEADS * ATTN_HEAD_DIM
ODD_IN = ATTN_Q_WIDTH + 2 * ATTN_KV_WIDTH
ROPE_THETA = 10000.0
ROPE_AXIS_PAIRS = ATTN_HEAD_DIM // 4

kernel_name = 'hybrid_hyena_gla_gqa_diffusion_trunk'


def layer_norm(x, g, b):
    xf = x.astype(jnp.float32)
    mu = jnp.mean(xf, -1, keepdims=True)
    var = jnp.mean(jnp.square(xf - mu), -1, keepdims=True)
    return ((xf - mu) * lax.rsqrt(var + LN_EPS) * g + b).astype(x.dtype)


def rms_norm(x, g):
    xf = x.astype(jnp.float32)
    return (xf * lax.rsqrt(jnp.mean(xf * xf, -1, keepdims=True) + RMS_EPS) * g).astype(x.dtype)


def mod_input(z, mm, slot):
    return z * (1.0 + mm[:, 3 * slot + 1]) + mm[:, 3 * slot]


def gated_post_norm(z, y, mm, slot, g, b):
    return layer_norm(DEEPNORM_ALPHA * z + mm[:, 3 * slot + 2] * y, g, b)


def swiglu(h, w1, w2):
    gate, up = jnp.split(h @ w1, 2, axis=-1)
    return (jax.nn.silu(gate) * up) @ w2


def ffn_sublayer(z, mm, slot, w1, w2, g, b):
    y = MACARON_WEIGHT * swiglu(mod_input(z, mm, slot), w1, w2)
    return gated_post_norm(z, y, mm, slot, g, b)


def split_sizes(t, sizes):
    idx, acc = [], 0
    for s in sizes[:-1]:
        acc += s
        idx.append(acc)
    return jnp.split(t, idx, axis=-1)


def short_conv3(u, w, b):
    up = jnp.pad(u, ((0, 0), (1, 1), (0, 0)))
    return up[:, :-2] * w[0] + up[:, 1:-1] * w[1] + up[:, 2:] * w[2] + b


def hyena_filter_spectrum(length, w1, b1, fr1, w2, b2, fr2, w3, b3):
    f32 = jnp.float32
    n = jnp.arange(length, dtype=f32)[:, None]
    t = jnp.linspace(0.0, 1.0, length, dtype=f32)[:, None]
    bands = jnp.linspace(1e-4, HYENA_BANDS - 1, HYENA_BANDS, dtype=f32)[None, :]
    ang = 2.0 * math.pi * n * bands / length
    feats = jnp.concatenate([t, jnp.cos(ang), -jnp.sin(ang)], axis=-1)
    h = jnp.sin(fr1.astype(f32) * (feats @ w1.astype(f32) + b1.astype(f32)))
    h = jnp.sin(fr2.astype(f32) * (h @ w2.astype(f32) + b2.astype(f32)))
    h = (h @ w3.astype(f32) + b3.astype(f32)).reshape(length, HYENA_FILTERS, 2, HYENA_WIDTH)
    max_decay = math.log(HYENA_TARGET) / HYENA_FAST_DECAY
    min_decay = math.log(HYENA_TARGET) / HYENA_SLOW_DECAY
    deltas = jnp.abs(jnp.linspace(min_decay, max_decay, HYENA_WIDTH, dtype=f32))
    h = h * jnp.exp(-t[:, :, None, None] * deltas)
    h_fwd, h_bwd = h[:, :, 0], h[:, :, 1]
    k = jnp.concatenate([h_fwd, jnp.zeros_like(h_fwd[:1]), jnp.flip(h_bwd[1:], axis=0)], axis=0)
    k = k * lax.rsqrt(jnp.sum(jnp.square(k), axis=0, keepdims=True) + 1e-6)
    return jnp.fft.rfft(k, axis=0)


def fft_long_conv(z, k_hat, skip):
    L = z.shape[1]
    z_hat = jnp.fft.rfft(z.astype(jnp.float32), n=2 * L, axis=1)
    y = jnp.fft.irfft(z_hat * k_hat, n=2 * L, axis=1)[:, :L]
    return (y + z.astype(jnp.float32) * skip).astype(z.dtype)


def hyena_mix(u, k_hat, conv_w, conv_b, skip):
    parts = jnp.split(short_conv3(u, conv_w, conv_b), HYENA_ORDER + 1, axis=-1)
    z = parts[0]
    for n in range(HYENA_FILTERS):
        z = fft_long_conv(z * parts[n + 1], k_hat[:, n], skip[n])
    return z * parts[HYENA_ORDER]


def gla_chunked(q, k, v, log_a, s0):
    f32 = jnp.float32
    Bn, L, H, _ = q.shape
    n = L // GLA_CHUNK

    def chunks(t):
        return t.reshape(Bn, n, GLA_CHUNK, H, t.shape[-1]).astype(f32)

    qc, kc, vc, gc = chunks(q), chunks(k), chunks(v), chunks(log_a)
    b = jnp.cumsum(gc, axis=2)
    b_last = b[:, :, -1:]
    q_in = qc * jnp.exp(b)
    k_in = kc * jnp.exp(-b)
    k_st = kc * jnp.exp(b_last - b)
    mask = jnp.tril(jnp.ones((GLA_CHUNK, GLA_CHUNK), dtype=bool))
    att = jnp.where(mask, jnp.einsum('bnchd,bnshd->bnhcs', q_in, k_in), 0.0)
    o_intra = jnp.einsum('bnhcs,bnshe->bnche', att, vc)
    ds = jnp.einsum('bnchd,bnche->nbhde', k_st, vc)
    decay = jnp.moveaxis(jnp.exp(b_last[:, :, 0]), 1, 0)

    def step(s, inp):
        dec, d = inp
        return dec[..., None] * s + d, s

    s_final, s_before = lax.scan(step, s0.astype(f32), (decay, ds))
    o_inter = jnp.einsum('bnchd,nbhde->bnche', q_in, s_before)
    o = (o_intra + o_inter).reshape(Bn, L, H, v.shape[-1])
    return o.astype(v.dtype), s_final


def gla_reverse(q, k, v, log_a, s0):
    o, s = gla_chunked(jnp.flip(q, 1), jnp.flip(k, 1), jnp.flip(v, 1), jnp.flip(log_a, 1), s0)
    return jnp.flip(o, 1), s


def even_mixer(a, ac, w_in, w_out, conv_w, conv_b, f_w1, f_b1, f_fr1, f_w2, f_b2, f_fr2, f_w3, f_b3,
               skip, gate_up, gate_b, norm_g, need_ctx):
    def project(z):
        Bn, L = z.shape[:2]
        hy, q, k, v, g, af, ab = split_sizes(z @ w_in, EVEN_SIZES)

        def heads(t, d):
            return t.reshape(Bn, L, GLA_HEADS, d)

        def log_gate(lo, j):
            return heads(jax.nn.log_sigmoid((lo @ gate_up[j] + gate_b[j]).astype(jnp.float32)) / GLA_TAU, GLA_DK)

        return (hy, heads(q, GLA_DK) * GLA_DK ** -0.5, heads(k, GLA_DK), heads(v, GLA_DV), g,
                log_gate(af, 0), log_gate(ab, 1))

    def hyena(hy):
        k_hat = hyena_filter_spectrum(hy.shape[1], f_w1, f_b1, f_fr1, f_w2, f_b2, f_fr2, f_w3, f_b3)
        return hyena_mix(hy, k_hat, conv_w, conv_b, skip)

    def gla_merge(o, g):
        Bn, L = g.shape[:2]
        return rms_norm(o, norm_g).reshape(Bn, L, GLA_WIDTH) * jax.nn.silu(g)

    hy, q, k, v, g, lf, lb = project(a)
    hyc, qc, kc, vc, gc, lfc, lbc = project(ac)
    s0 = jnp.zeros((ac.shape[0], GLA_HEADS, GLA_DK, GLA_DV), jnp.float32)
    oc_f, sc_f = gla_chunked(qc, kc, vc, lfc, s0)
    oc_b, sc_b = gla_reverse(qc, kc, vc, lbc, s0)
    o_f, _ = gla_chunked(q, k, v, lf, sc_f)
    o_b, _ = gla_reverse(q, k, v, lb, sc_b)
    y = jnp.concatenate([hyena(hy), gla_merge(o_f + o_b, g)], axis=-1) @ w_out
    yc = jnp.concatenate([hyena(hyc), gla_merge(oc_f + oc_b, gc)], axis=-1) @ w_out if need_ctx else None
    return y, yc


def rope_axis(x, ang):
    c = jnp.cos(ang)[None, :, None, :]
    s = jnp.sin(ang)[None, :, None, :]
    x1, x2 = jnp.split(x.astype(jnp.float32), 2, axis=-1)
    return jnp.concatenate([x1 * c - x2 * s, x2 * c + x1 * s], axis=-1)


def rope_2d(x, ang_r, ang_c):
    xr, xc = jnp.split(x, 2, axis=-1)
    return jnp.concatenate([rope_axis(xr, ang_r), rope_axis(xc, ang_c)], axis=-1).astype(x.dtype)


def gqa_attend(q, k, v):
    Bn, Lq = q.shape[:2]
    qg = q.reshape(Bn, Lq, ATTN_KV_HEADS, ATTN_GROUP, ATTN_HEAD_DIM)
    s = jnp.einsum('bqkgd,bskd->bkgqs', qg, k, preferred_element_type=jnp.float32) * ATTN_HEAD_DIM ** -0.5
    p = jax.nn.softmax(s, axis=-1).astype(v.dtype)
    o = jnp.einsum('bkgqs,bskd->bqkgd', p, v)
    return o.reshape(Bn, Lq, ATTN_Q_WIDTH)


def odd_mixer(a, ac, w_in, w_out, q_norm, k_norm, ang_r, ang_c, need_ctx):
    def project(z):
        Bn, L = z.shape[:2]
        q, k, v = jnp.split(z @ w_in, [ATTN_Q_WIDTH, ATTN_Q_WIDTH + ATTN_KV_WIDTH], axis=-1)
        q = rms_norm(q.reshape(Bn, L, ATTN_Q_HEADS, ATTN_HEAD_DIM), q_norm)
        k = rms_norm(k.reshape(Bn, L, ATTN_KV_HEADS, ATTN_HEAD_DIM), k_norm)
        return q, k, v.reshape(Bn, L, ATTN_KV_HEADS, ATTN_HEAD_DIM)

    q, k, v = project(a)
    q, k = rope_2d(q, ang_r, ang_c), rope_2d(k, ang_r, ang_c)
    qc, kc, vc = project(ac)
    k_all = jnp.concatenate([k, kc], axis=1)
    v_all = jnp.concatenate([v, vc], axis=1)
    Bn, S = a.shape[:2]
    q_blocks = q.reshape(Bn, S // ATTN_BLOCK, ATTN_BLOCK, ATTN_Q_HEADS, ATTN_HEAD_DIM).swapaxes(0, 1)
    o = lax.map(lambda qb: gqa_attend(qb, k_all, v_all), q_blocks)
    y = o.swapaxes(0, 1).reshape(Bn, S, ATTN_Q_WIDTH) @ w_out
    yc = gqa_attend(qc, kc, vc) @ w_out if need_ctx else None
    return y, yc


def setup_inputs(seed: int = 0) -> dict:
    key = jax.random.key(seed)
    ks = iter(jax.random.split(key, 48))
    f32 = jnp.float32
    D = D_MODEL

    def nrm(shape, scale):
        return scale * jax.random.normal(next(ks), shape, f32)

    return {
        'x': nrm((BATCH, SEQ, D), 1.0),
        'c': nrm((BATCH, D), 1.0),
        'ctx': nrm((BATCH, CTX_LEN, D), 1.0),
        'c_ctx': nrm((D,), 1.0),
        'ada_w': nrm((DEPTH, D, N_MOD * D), D ** -0.5),
        'ada_b': nrm((DEPTH, N_MOD * D), 0.02),
        'ln_g': 1.0 + nrm((DEPTH, 3, D), 0.02),
        'ln_b': nrm((DEPTH, 3, D), 0.02),
        'ffn_w1': nrm((DEPTH, 2, D, 2 * FFN_HIDDEN), D ** -0.5),
        'ffn_w2': nrm((DEPTH, 2, FFN_HIDDEN, D), DEEPNORM_BETA * FFN_HIDDEN ** -0.5),
        'even_w_in': nrm((N_EVEN, D, EVEN_IN), D ** -0.5),
        'even_w_out': nrm((N_EVEN, D, D), DEEPNORM_BETA * D ** -0.5),
        'hyena_conv_w': nrm((N_EVEN, 3, HYENA_PROJ), 3 ** -0.5),
        'hyena_conv_b': nrm((N_EVEN, HYENA_PROJ), 0.02),
        'hyena_f_w1': nrm((N_EVEN, HYENA_EMB, HYENA_FILTER_HIDDEN), HYENA_EMB ** -0.5),
        'hyena_f_b1': nrm((N_EVEN, HYENA_FILTER_HIDDEN), 0.1),
        'hyena_f_fr1': 1.0 + nrm((N_EVEN, HYENA_FILTER_HIDDEN), 0.1),
        'hyena_f_w2': nrm((N_EVEN, HYENA_FILTER_HIDDEN, HYENA_FILTER_HIDDEN), HYENA_FILTER_HIDDEN ** -0.5),
        'hyena_f_b2': nrm((N_EVEN, HYENA_FILTER_HIDDEN), 0.1),
        'hyena_f_fr2': 1.0 + nrm((N_EVEN, HYENA_FILTER_HIDDEN), 0.1),
        'hyena_f_w3': nrm((N_EVEN, HYENA_FILTER_HIDDEN, HYENA_FILTERS * 2 * HYENA_WIDTH), HYENA_FILTER_HIDDEN ** -0.5),
        'hyena_f_b3': nrm((N_EVEN, HYENA_FILTERS * 2 * HYENA_WIDTH), 0.02),
        'hyena_skip': nrm((N_EVEN, HYENA_FILTERS, HYENA_WIDTH), 0.1),
        'gla_gate_up': nrm((N_EVEN, 2, GLA_RANK, GLA_QK), GLA_RANK ** -0.5),
        'gla_gate_b': nrm((N_EVEN, 2, GLA_QK), 0.1),
        'gla_norm_g': 1.0 + nrm((N_EVEN, GLA_DV), 0.02),
        'attn_w_in': nrm((N_ODD, D, ODD_IN), D ** -0.5),
        'attn_w_out': nrm((N_ODD, D, D), DEEPNORM_BETA * D ** -0.5),
        'attn_q_norm': 1.0 + nrm((N_ODD, ATTN_HEAD_DIM), 0.02),
        'attn_k_norm': 1.0 + nrm((N_ODD, ATTN_HEAD_DIM), 0.02),
    }


def reference(x, c, ctx, c_ctx, ada_w, ada_b, ln_g, ln_b, ffn_w1, ffn_w2, even_w_in, even_w_out,
              hyena_conv_w, hyena_conv_b, hyena_f_w1, hyena_f_b1, hyena_f_fr1, hyena_f_w2, hyena_f_b2,
              hyena_f_fr2, hyena_f_w3, hyena_f_b3, hyena_skip, gla_gate_up, gla_gate_b, gla_norm_g,
              attn_w_in, attn_w_out, attn_q_norm, attn_k_norm):
    f32 = jnp.float32
    Bn, S = x.shape[:2]
    rows = S // GRID_W
    row = jnp.repeat(jnp.arange(rows, dtype=f32), GRID_W)
    col = jnp.tile(jnp.arange(GRID_W, dtype=f32), rows)
    inv_freq = ROPE_THETA ** (-jnp.arange(ROPE_AXIS_PAIRS, dtype=f32) / ROPE_AXIS_PAIRS)
    ang_r = row[:, None] * inv_freq
    ang_c = col[:, None] * inv_freq
    sc = jax.nn.silu(c)
    sc_ctx = jax.nn.silu(c_ctx)
    h, hc = x, ctx
    for i in range(DEPTH):
        need_ctx = i < DEPTH - 1
        m = (sc @ ada_w[i] + ada_b[i]).reshape(Bn, N_MOD, 1, D_MODEL)
        mc = (sc_ctx @ ada_w[i] + ada_b[i]).reshape(1, N_MOD, 1, D_MODEL)
        h = ffn_sublayer(h, m, 0, ffn_w1[i, 0], ffn_w2[i, 0], ln_g[i, 0], ln_b[i, 0])
        hc = ffn_sublayer(hc, mc, 0, ffn_w1[i, 0], ffn_w2[i, 0], ln_g[i, 0], ln_b[i, 0])
        a, ac = mod_input(h, m, 1), mod_input(hc, mc, 1)
        if i % 2 == 0:
            e = i // 2
            y, yc = even_mixer(a, ac, even_w_in[e], even_w_out[e], hyena_conv_w[e], hyena_conv_b[e],
                               hyena_f_w1[e], hyena_f_b1[e], hyena_f_fr1[e], hyena_f_w2[e], hyena_f_b2[e],
                               hyena_f_fr2[e], hyena_f_w3[e], hyena_f_b3[e], hyena_skip[e],
                               gla_gate_up[e], gla_gate_b[e], gla_norm_g[e], need_ctx)
        else:
            o = i // 2
            y, yc = odd_mixer(a, ac, attn_w_in[o], attn_w_out[o], attn_q_norm[o], attn_k_norm[o],
                              ang_r, ang_c, need_ctx)
        h = gated_post_norm(h, y, m, 1, ln_g[i, 1], ln_b[i, 1])
        h = ffn_sublayer(h, m, 2, ffn_w1[i, 1], ffn_w2[i, 1], ln_g[i, 2], ln_b[i, 2])
        if need_ctx:
            hc = gated_post_norm(hc, yc, mc, 1, ln_g[i, 1], ln_b[i, 1])
            hc = ffn_sublayer(hc, mc, 2, ffn_w1[i, 1], ffn_w2[i, 1], ln_g[i, 2], ln_b[i, 2])
    return h
```

```cpp
#include <hip/hip_runtime.h>
#include <hip/hip_cooperative_groups.h>
#include <cstdio>
#include <cstdint>
#include <cmath>
namespace cg = cooperative_groups;

constexpr int DM = 1024, NBATCH = 8, SEQ = 2048, CTXL = 256;
constexpr int R_LAT = NBATCH * SEQ, R_CTX = NBATCH * CTXL, R_ALL = R_LAT + R_CTX;
constexpr int FH = 2816, EIN = 3104, EINP = 3328, OIN = 1536, NMODC = 9216;
constexpr float ALPHA = 1.681792830507429f;
constexpr float LN_EPS = 1e-5f, RMS_EPS = 1e-6f;
constexpr int NPHASES = 48;

constexpr size_t al256(size_t x) { return (x + 255) / 256 * 256; }
constexpr size_t WS_WT1 = 0;
constexpr size_t WS_WT2 = WS_WT1 + 8ull * 5632 * 1024 * 2;
constexpr size_t WS_WEI = WS_WT2 + 8ull * 1024 * 2816 * 2;
constexpr size_t WS_WEO = WS_WEI + 2ull * EINP * 1024 * 2;
constexpr size_t WS_WAI = WS_WEO + 2ull * 1024 * 1024 * 2;
constexpr size_t WS_WAO = WS_WAI + 2ull * OIN * 1024 * 2;
constexpr size_t WS_MODV = WS_WAO + 2ull * 1024 * 1024 * 2;
constexpr size_t WS_KFL = WS_MODV + al256(4ull * 9 * NMODC * 4);
constexpr size_t WS_KFC = WS_KFL + 2ull * 2 * 512 * 2048 * 4;
constexpr size_t WS_H = WS_KFC + 2ull * 2 * 512 * 256 * 4;
constexpr size_t WS_A = WS_H + (size_t)R_ALL * 1024 * 4;
constexpr size_t WS_U = WS_A + (size_t)R_ALL * 1024 * 2;
constexpr size_t WS_ACT = WS_U;
constexpr size_t WS_PROJ = WS_U;
constexpr size_t WS_MIX = WS_PROJ + (size_t)R_ALL * EINP * 2;
constexpr size_t WS_GLO = WS_MIX + (size_t)R_ALL * 1024 * 2;
constexpr size_t WS_X = WS_GLO + (size_t)R_ALL * 32 * 4;
constexpr size_t WS_P2 = WS_X;
constexpr size_t WS_ZTL = WS_P2 + (size_t)R_ALL * 512 * 2;
constexpr size_t WS_ZTC = WS_ZTL + 512ull * 8 * 2048 * 2;
constexpr size_t WS_DS = WS_ZTC + 512ull * 8 * 256 * 2;
constexpr size_t WS_DEC = WS_DS + 64ull * 36 * 8192 * 4;
constexpr size_t WS_SB = WS_DEC + 64ull * 36 * 64 * 4;
constexpr size_t WS_END_E = WS_SB + 64ull * 36 * 8192 * 2;
constexpr size_t WS_QB = WS_X;
constexpr size_t WS_KB = WS_QB + (size_t)R_ALL * 1024 * 2;
constexpr size_t WS_VB = WS_KB + 8ull * 2 * 2304 * 128 * 2;
constexpr size_t WS_END = WS_END_E;
constexpr int LDS_BYTES = 136 * 1024;

typedef float f32x4 __attribute__((ext_vector_type(4)));
typedef unsigned u32x4 __attribute__((ext_vector_type(4)));
typedef unsigned u32x2 __attribute__((ext_vector_type(2)));

__device__ __forceinline__ unsigned f2bf(float f) { unsigned u = __builtin_bit_cast(unsigned, f); return (u + 0x7fffu + ((u >> 16) & 1u)) >> 16; }
__device__ __forceinline__ unsigned pk2(float lo, float hi) { return f2bf(lo) | (f2bf(hi) << 16); }
__device__ __forceinline__ float bf2f(unsigned short h) { return __builtin_bit_cast(float, (unsigned)h << 16); }
__device__ __forceinline__ float bflo(unsigned w) { return __builtin_bit_cast(float, w << 16); }
__device__ __forceinline__ float bfhi(unsigned w) { return __builtin_bit_cast(float, w & 0xffff0000u); }
__device__ __forceinline__ float silu_f(float x) { return x * __builtin_amdgcn_rcpf(1.f + __expf(-x)); }
__device__ __forceinline__ float wave_sum(float v) {
#pragma unroll
    for (int o = 1; o < 64; o <<= 1) v += __shfl_xor(v, o);
    return v;
}
#define LDS_WAIT() asm volatile("s_waitcnt lgkmcnt(0)" ::: "memory")
__device__ __forceinline__ int otid() { int t = threadIdx.x; asm volatile("" : "+v"(t)); return t; }
namespace pg8 {
#define PG8_LAS __attribute__((address_space(3)))
typedef unsigned short bf16_t;
typedef short bf16x8 __attribute__((ext_vector_type(8)));
typedef float f32x4 __attribute__((ext_vector_type(4)));
typedef unsigned u32x4 __attribute__((ext_vector_type(4)));
constexpr int BM = 256, BK = 64, HALF = 128, HTB = HALF * BK * 2  , STAGE_BYTES = 8 * HTB, NXCD = 8, WGM = 8;

__host__ __device__ __forceinline__ int lds_byte(int r, int c) { const int st = (r >> 4) * 2 + (c >> 5), rr = r & 15, cc = c & 31, ob = rr * 64 + cc * 2; return st * 1024 + (ob ^ (((ob >> 9) & 1) << 5)); }
__host__ __device__ __forceinline__ void stage_rc(int b, int& R, int& C) { const int st = b / 1024, sb = b % 1024, swz = sb ^ (((sb >> 9) & 1) << 5); R = (st >> 1) * 16 + swz / 64; C = (st & 1) * 32 + (swz % 64) / 2; }
__host__ __device__ __forceinline__ int perm32(int rho) { const int n = rho >> 4, i = rho & 15; return 8 * (i >> 2) + 4 * n + (i & 3); }

struct Unit { int pm, pn; };
struct Gemm { const bf16_t* A; const bf16_t* Bt; int M, N, K; };

struct StaticOrder {
    int nM, nN, nwg, G, c;
    __host__ __device__ void init(int M, int N, int G_, int c_) { nM = M / BM; nN = N / BM; nwg = nM * nN; G = G_; c = c_; }
    __host__ __device__ bool next(int i, Unit& u) const {
        const long L = (long)i * G + c; if (L >= nwg) return false;
        int wgid = (int)L; { const int q = nwg / NXCD, r = nwg % NXCD, xcd = wgid % NXCD, off = wgid / NXCD; wgid = (xcd < r ? xcd * (q + 1) : r * (q + 1) + (xcd - r) * q) + off; }
        const int nig = WGM * nN, gid = wgid / nig, fm = gid * WGM, gsz = (nM - fm) < WGM ? (nM - fm) : WGM;
        u.pm = fm + ((wgid % nig) % gsz); u.pn = (wgid % nig) / gsz; return true;
    }
    __device__ __forceinline__ void a_ready(const Unit&) const {}
    __device__ __forceinline__ void done(const Unit&) const {}
};

struct EpiSwiglu {
    static constexpr bool PERM = true, AFTER_DRAIN = false;
    bf16_t* O;
    __device__ __forceinline__ void operator()(const f32x4 (&acc)[2][2][4][2], const Unit& u, int wr, int wc, int fr, int fq) const {
        const int row0 = u.pm * BM + wr * 64 + fr, col0 = u.pn * 128 + wc * 32 + 8 * fq;
#pragma unroll
        for (int ai = 0; ai < 2; ++ai)
#pragma unroll
            for (int m = 0; m < 4; ++m) {
                bf16_t* rowp = O + (size_t)(row0 + ai * HALF + m * 16) * FH + col0;
                const f32x4 g0 = acc[ai][0][m][0], g1 = acc[ai][0][m][1], u0 = acc[ai][1][m][0], u1 = acc[ai][1][m][1];
                u32x4 w;
                w.x = pk2(silu_f(g0[0]) * u0[0], silu_f(g0[1]) * u0[1]); w.y = pk2(silu_f(g0[2]) * u0[2], silu_f(g0[3]) * u0[3]);
                w.z = pk2(silu_f(g1[0]) * u1[0], silu_f(g1[1]) * u1[1]); w.w = pk2(silu_f(g1[2]) * u1[2], silu_f(g1[3]) * u1[3]);
                *(u32x4*)rowp = w;
            }
    }
};
struct EpiResid {
    static constexpr bool PERM = false, AFTER_DRAIN = false;
    float* H; const float* gate; float scale;
    __device__ __forceinline__ void operator()(const f32x4 (&acc)[2][2][4][2], const Unit& u, int wr, int wc, int fr, int fq) const {
        const int b = u.pm < 64 ? (u.pm >> 3) : 8;
        const float* gt = gate + (size_t)b * NMODC;
        const int row0 = u.pm * BM + wr * 64 + fr, col0 = u.pn * BM + wc * 32 + 4 * fq;
#pragma unroll
        for (int bj = 0; bj < 2; ++bj)
#pragma unroll
            for (int n = 0; n < 2; ++n) {
                const f32x4 gv = *(const f32x4*)(gt + col0 + bj * HALF + n * 16) * scale;
#pragma unroll
                for (int ai = 0; ai < 2; ++ai)
#pragma unroll
                    for (int m = 0; m < 4; ++m) {
                        float* ptr = H + (size_t)(row0 + ai * HALF + m * 16) * DM + col0 + bj * HALF + n * 16;
                        const f32x4 h = *(const f32x4*)ptr;
                        *(f32x4*)ptr = h * ALPHA + gv * acc[ai][bj][m][n];
                    }
            }
    }
};
struct EpiProj {
    static constexpr bool PERM = true, AFTER_DRAIN = false;
    bf16_t* O; int ldc; int f32_start; float* GL;
    __device__ __forceinline__ void operator()(const f32x4 (&acc)[2][2][4][2], const Unit& u, int wr, int wc, int fr, int fq) const {
        const int row0 = u.pm * BM + wr * 64 + fr, colt = u.pn * BM;
        if (colt >= f32_start) {
            if (wc == 0) {
#pragma unroll
                for (int ai = 0; ai < 2; ++ai)
#pragma unroll
                    for (int m = 0; m < 4; ++m) {
                        float* gp = GL + (size_t)(row0 + ai * HALF + m * 16) * 32 + 8 * fq;
                        *(f32x4*)gp = acc[ai][0][m][0]; *(f32x4*)(gp + 4) = acc[ai][0][m][1];
                    }
            }
        } else {
            const int col0 = colt + wc * 32 + 8 * fq;
#pragma unroll
            for (int ai = 0; ai < 2; ++ai)
#pragma unroll
                for (int m = 0; m < 4; ++m) {
                    bf16_t* rowp = O + (size_t)(row0 + ai * HALF + m * 16) * ldc + col0;
#pragma unroll
                    for (int bj = 0; bj < 2; ++bj) {
                        const f32x4 v0 = acc[ai][bj][m][0], v1 = acc[ai][bj][m][1];
                        u32x4 w; w.x = pk2(v0[0], v0[1]); w.y = pk2(v0[2], v0[3]); w.z = pk2(v1[0], v1[1]); w.w = pk2(v1[2], v1[3]);
                        *(u32x4*)(rowp + bj * HALF) = w;
                    }
                }
        }
    }
};
template <class Epi, class Sched, bool ALIGN_EPI = false, bool SP2 = false>
__device__ __forceinline__ void gemm_phase(PG8_LAS unsigned char* lds, const Gemm g, const Sched& S, const Epi& E) {
    const int tid = otid(), wid = __builtin_amdgcn_readfirstlane(tid >> 6), lane = tid & 63, wr = wid >> 2, wc = wid & 3, fr = lane & 15, fq = lane >> 4;
    const int K = g.K, nt = K / BK;
    unsigned voffA[2], voffB[2];
#pragma unroll
    for (int i = 0; i < 2; ++i) { int R, C; stage_rc(tid * 16 + i * 8192, R, C); const int Rb = Epi::PERM ? ((R & ~31) + perm32(R & 31)) : R;
        voffA[i] = (unsigned)(R * K + C) * 2u; voffB[i] = (unsigned)(Rb * K + C) * 2u; }
    const size_t kstep = (size_t)(BK * 2);
    const size_t hstep = (size_t)HALF * K * 2;
    const size_t tstep = 2 * hstep;
    const unsigned ldsw = (unsigned)wid * 1024u;
    const int aoff = lds_byte(wr * 64 + fr, fq * 8), boff = lds_byte(wc * 32 + fr, fq * 8);
#define PG8_SA(b, h) (((b) * 2 + (h)) * HTB)
#define PG8_SB(b, h) ((4 + (b) * 2 + (h)) * HTB)
#define PG8_STAGE(bufoff, gbase, voff) do { _Pragma("unroll") for (int _i = 0; _i < 2; ++_i) \
        __builtin_amdgcn_global_load_lds((const unsigned*)((const char*)(gbase) + (voff)[_i]), (PG8_LAS unsigned*)(lds + (bufoff) + ldsw + _i * 8192), 16, 0, 0); } while (0)
#define PG8_LDA(dst, b, h) do { _Pragma("unroll") for (int m = 0; m < 4; ++m) _Pragma("unroll") for (int k = 0; k < 2; ++k) dst[m][k] = *(const PG8_LAS bf16x8*)(lds + PG8_SA(b, h) + aoff + m * 2048 + k * 1024); } while (0)
#define PG8_LDB(dst, b, h) do { _Pragma("unroll") for (int n = 0; n < 2; ++n) _Pragma("unroll") for (int k = 0; k < 2; ++k) dst[n][k] = *(const PG8_LAS bf16x8*)(lds + PG8_SB(b, h) + boff + n * 2048 + k * 1024); } while (0)
#define PG8_MMA(ai, bj, At, Bt) do { __builtin_amdgcn_s_setprio(1); _Pragma("unroll") for (int m = 0; m < 4; ++m) _Pragma("unroll") for (int n = 0; n < 2; ++n) _Pragma("unroll") for (int k = 0; k < 2; ++k) \
        acc[ai][bj][m][n] = __builtin_amdgcn_mfma_f32_16x16x32_bf16(Bt[n][k], At[m][k], acc[ai][bj][m][n], 0, 0, 0); __builtin_amdgcn_s_setprio(0); } while (0)
#define PG8_WAIT_V(n) asm volatile("s_waitcnt vmcnt(" #n ")" ::: "memory")
#define PG8_WAIT_L(n) asm volatile("s_waitcnt lgkmcnt(" #n ")" ::: "memory")
#define PG8_BAR __builtin_amdgcn_s_barrier()
#define PG8_SCHED __builtin_amdgcn_sched_barrier(0)
    Unit cur, nxt; int ui = 0;
    if (!S.next(0, cur)) return;
    f32x4 acc[2][2][4][2];
#pragma unroll
    for (int a = 0; a < 2; ++a)
#pragma unroll
        for (int b = 0; b < 2; ++b)
#pragma unroll
            for (int m = 0; m < 4; ++m)
#pragma unroll
                for (int n = 0; n < 2; ++n) acc[a][b][m][n] = (f32x4){0.f, 0.f, 0.f, 0.f};
    bf16x8 At[4][2], B0[2][2], B1[2][2];
    const char* cA = (const char*)g.A + (size_t)cur.pm * tstep; const char* cB = (const char*)g.Bt + (size_t)cur.pn * tstep;
    S.a_ready(cur);
    if constexpr (SP2) {
        PG8_STAGE(PG8_SB(0, 0), cB, voffB); PG8_STAGE(PG8_SB(0, 1), cB + hstep, voffB); PG8_STAGE(PG8_SA(0, 0), cA, voffA); PG8_STAGE(PG8_SA(0, 1), cA + hstep, voffA);
        if (wr == 1) PG8_BAR;
        PG8_WAIT_V(2); PG8_BAR;
        PG8_STAGE(PG8_SB(1, 0), cB + kstep, voffB); PG8_STAGE(PG8_SA(1, 0), cA + kstep, voffA); PG8_STAGE(PG8_SB(1, 1), cB + hstep + kstep, voffB);
        PG8_WAIT_V(6); PG8_BAR;
    } else {
        PG8_STAGE(PG8_SB(0, 0), cB, voffB); PG8_STAGE(PG8_SA(0, 0), cA, voffA); PG8_STAGE(PG8_SB(0, 1), cB + hstep, voffB); PG8_STAGE(PG8_SA(0, 1), cA + hstep, voffA);
        if (wr == 1) PG8_BAR;
        PG8_WAIT_V(4); PG8_BAR;
        PG8_STAGE(PG8_SB(1, 0), cB + kstep, voffB); PG8_STAGE(PG8_SA(1, 0), cA + kstep, voffA); PG8_STAGE(PG8_SB(1, 1), cB + hstep + kstep, voffB);
        PG8_WAIT_V(6); PG8_BAR;
    }
    for (;;) {
        const bool has_next = S.next(ui + 1, nxt);
        const char* nA = has_next ? (const char*)g.A + (size_t)nxt.pm * tstep : cA; const char* nB = has_next ? (const char*)g.Bt + (size_t)nxt.pn * tstep : cB;
        for (int t = 0; t < nt; t += 2) {
            const bool last = (t == nt - 2);
            const char* a1 = cA + (size_t)(t + 1) * kstep;
            const char* a2 = last ? nA : cA + (size_t)(t + 2) * kstep; const char* b2 = last ? nB : cB + (size_t)(t + 2) * kstep;
            const char* a3 = a2 + kstep; const char* b3 = b2 + kstep;
            if (last && has_next) S.a_ready(nxt);
            if constexpr (SP2) {
            PG8_LDB(B0, 0, 0); PG8_LDB(B1, 0, 1); PG8_SCHED; PG8_LDA(At, 0, 0); PG8_STAGE(PG8_SA(1, 1), a1 + hstep, voffA);
            PG8_WAIT_V(8); PG8_WAIT_L(0); PG8_BAR; PG8_MMA(0, 0, At, B0); PG8_MMA(0, 1, At, B1); PG8_BAR; PG8_SCHED;
            PG8_LDA(At, 0, 1); PG8_STAGE(PG8_SB(0, 0), b2, voffB); PG8_STAGE(PG8_SB(0, 1), b2 + hstep, voffB); PG8_STAGE(PG8_SA(0, 0), a2, voffA);
            PG8_WAIT_V(8); PG8_WAIT_L(0); PG8_BAR; PG8_MMA(1, 0, At, B0); PG8_MMA(1, 1, At, B1); PG8_BAR; PG8_SCHED;
            PG8_LDB(B0, 1, 0); PG8_LDB(B1, 1, 1); PG8_SCHED; PG8_LDA(At, 1, 0); PG8_STAGE(PG8_SA(0, 1), a2 + hstep, voffA);
            PG8_WAIT_V(8); PG8_WAIT_L(0); PG8_BAR; PG8_MMA(0, 0, At, B0); PG8_MMA(0, 1, At, B1); PG8_BAR; PG8_SCHED;
            PG8_LDA(At, 1, 1); PG8_STAGE(PG8_SB(1, 0), b3, voffB); PG8_STAGE(PG8_SB(1, 1), b3 + hstep, voffB); PG8_STAGE(PG8_SA(1, 0), a3, voffA);
            PG8_WAIT_V(8); PG8_WAIT_L(0); PG8_BAR; PG8_MMA(1, 0, At, B0); PG8_MMA(1, 1, At, B1); PG8_BAR; PG8_SCHED;
            } else {
            PG8_LDB(B0, 0, 0); PG8_SCHED; PG8_LDA(At, 0, 0); PG8_STAGE(PG8_SA(1, 1), a1 + hstep, voffA);
            PG8_WAIT_L(8); PG8_BAR; PG8_WAIT_L(0); PG8_MMA(0, 0, At, B0); PG8_BAR; PG8_SCHED;
            PG8_LDB(B1, 0, 1); PG8_STAGE(PG8_SB(0, 0), b2, voffB);
            PG8_BAR; PG8_WAIT_L(0); PG8_MMA(0, 1, At, B1); PG8_BAR;
            PG8_LDA(At, 0, 1); PG8_STAGE(PG8_SA(0, 0), a2, voffA);
            PG8_BAR; PG8_WAIT_L(0); PG8_MMA(1, 0, At, B0); PG8_BAR; PG8_SCHED;
            PG8_STAGE(PG8_SB(0, 1), b2 + hstep, voffB);
            PG8_WAIT_V(6); PG8_BAR; PG8_MMA(1, 1, At, B1); PG8_BAR;
            PG8_LDB(B0, 1, 0); PG8_SCHED; PG8_LDA(At, 1, 0); PG8_STAGE(PG8_SA(0, 1), a2 + hstep, voffA);
            PG8_WAIT_L(8); PG8_BAR; PG8_WAIT_L(0); PG8_MMA(0, 0, At, B0); PG8_BAR; PG8_SCHED;
            PG8_LDB(B1, 1, 1); PG8_STAGE(PG8_SB(1, 0), b3, voffB);
            PG8_BAR; PG8_WAIT_L(0); PG8_MMA(0, 1, At, B1); PG8_BAR;
            PG8_LDA(At, 1, 1); PG8_STAGE(PG8_SA(1, 0), a3, voffA);
            PG8_BAR; PG8_WAIT_L(0); PG8_MMA(1, 0, At, B0); PG8_BAR; PG8_SCHED;
            PG8_STAGE(PG8_SB(1, 1), b3 + hstep, voffB);
            PG8_WAIT_V(6); PG8_BAR; PG8_MMA(1, 1, At, B1); PG8_BAR;
            }
        }
        if constexpr (ALIGN_EPI) { if (wr == 0) PG8_BAR; }
        if constexpr (!Epi::AFTER_DRAIN) { E(acc, cur, wr, wc, fr, fq); S.done(cur); }
        if (!has_next) break;
#pragma unroll
        for (int a = 0; a < 2; ++a)
#pragma unroll
            for (int b = 0; b < 2; ++b)
#pragma unroll
                for (int m = 0; m < 4; ++m)
#pragma unroll
                    for (int n = 0; n < 2; ++n) acc[a][b][m][n] = (f32x4){0.f, 0.f, 0.f, 0.f};
        cur = nxt; cA = nA; cB = nB; ++ui;
        if constexpr (ALIGN_EPI) { if (wr == 1) PG8_BAR; }
    }
    PG8_WAIT_V(0);
    if constexpr (!ALIGN_EPI) { if (wr == 0) PG8_BAR; }
    PG8_BAR;
    if constexpr (Epi::AFTER_DRAIN) { E.fused(acc, cur, wr, wc, fr, fq, lds, wid, lane); S.done(cur); }
#undef PG8_SA
#undef PG8_SB
#undef PG8_STAGE
#undef PG8_LDA
#undef PG8_LDB
#undef PG8_MMA
#undef PG8_WAIT_V
#undef PG8_WAIT_L
#undef PG8_BAR
#undef PG8_SCHED
}
}
namespace attn {
using bf16 = unsigned short;
constexpr int   D = 128, NW = 8, QBLK = 32, KVBLK = 64;
constexpr float SCALE = 0.088388347648318440f;
constexpr float THR = 8.f;
constexpr int SDEPTH = 2;
constexpr int LDQ = 1024, LDK = 128, LDO = 1024;
constexpr size_t SHM_V = KVBLK * D * 2, SHM_K = KVBLK * D * 2, SHM_ATTN = 2 * SHM_V + 2 * SHM_K + NW * 64 * 4;
using bf16x8 = __attribute__((ext_vector_type(8))) short;
using s16x4  = __attribute__((ext_vector_type(4))) short;
using f32x16 = __attribute__((ext_vector_type(16))) float;
using f32x8  = __attribute__((ext_vector_type(8))) float;
using u32x4  = __attribute__((ext_vector_type(4))) unsigned;
#define KSWZ(row, colB) ((row) * 256 + ((colB) ^ (((row) & 7) << 4)))
#define SBAR() __builtin_amdgcn_sched_barrier(0)
__device__ __forceinline__ int crow(int r, int hi) { return (r & 3) + 8 * (r >> 2) + 4 * hi; }
__device__ __forceinline__ unsigned cvtpk(float lo, float hi) {
  unsigned r; asm volatile("v_cvt_pk_bf16_f32 %0, %1, %2" : "=v"(r) : "v"(lo), "v"(hi)); return r;
}
template <typename TIn> struct Stage;
template <> struct Stage<bf16>  { using T = bf16x8;
  __device__ static __forceinline__ T ld8(const bf16* p) { return *reinterpret_cast<const bf16x8*>(p); }
  __device__ static __forceinline__ bf16x8 tobf(T x) { return x; } };
template <> struct Stage<float> { using T = f32x8;
  __device__ static __forceinline__ T ld8(const float* p) { return *reinterpret_cast<const f32x8*>(p); }
  __device__ static __forceinline__ bf16x8 tobf(T x) {
    u32x4 w = {cvtpk(x[0], x[1]), cvtpk(x[2], x[3]), cvtpk(x[4], x[5]), cvtpk(x[6], x[7])}; return *reinterpret_cast<bf16x8*>(&w); } };

__device__ __forceinline__ void partialSM(f32x16& p0, f32x16& p1, float& m_reg, float& mn, float& alpha) {
  constexpr float C = SCALE * 1.4426950408889634f;
  float pmax = p0[0]; for (int r = 1; r < 16; ++r) pmax = fmaxf(pmax, p0[r]); for (int r = 0; r < 16; ++r) pmax = fmaxf(pmax, p1[r]);
  { auto rr = __builtin_amdgcn_permlane32_swap(__float_as_uint(pmax), __float_as_uint(pmax), false, false);
    pmax = fmaxf(__uint_as_float(rr[0]), __uint_as_float(rr[1])); }
  if (__builtin_expect(__all(pmax - m_reg <= THR / SCALE), 1)) { mn = m_reg; alpha = 1.f; }
  else { mn = fmaxf(m_reg, pmax); alpha = __builtin_amdgcn_exp2f((m_reg - mn) * C); m_reg = mn; }
  float mnC = -mn * C;
  for (int r = 0; r < 16; ++r) p0[r] = fmaf(p0[r], C, mnC); for (int r = 0; r < 16; ++r) p1[r] = fmaf(p1[r], C, mnC);
  for (int r = 0; r < 16; ++r) p0[r] = __builtin_amdgcn_exp2f(p0[r]);
}
__device__ __forceinline__ void finishSM(f32x16& p0, f32x16& p1, float alpha, float& l_reg, bf16x8& pa0, bf16x8& pa1, bf16x8& pa2, bf16x8& pa3) {
  for (int r = 0; r < 16; ++r) p1[r] = __builtin_amdgcn_exp2f(p1[r]);
  float ps = 0; for (int r = 0; r < 16; ++r) ps += p0[r]; for (int r = 0; r < 16; ++r) ps += p1[r];
  { auto rr = __builtin_amdgcn_permlane32_swap(__float_as_uint(ps), __float_as_uint(ps), false, false);
    ps = __uint_as_float(rr[0]) + __uint_as_float(rr[1]); }
  l_reg = l_reg * alpha + ps;
#define PK4(P, BASE, OUT) do { unsigned a0 = cvtpk(P[BASE + 0], P[BASE + 1]), a1 = cvtpk(P[BASE + 2], P[BASE + 3]);   \
    unsigned b0 = cvtpk(P[BASE + 4], P[BASE + 5]), b1 = cvtpk(P[BASE + 6], P[BASE + 7]);                              \
    auto r0 = __builtin_amdgcn_permlane32_swap(a0, b0, false, false); auto r1 = __builtin_amdgcn_permlane32_swap(a1, b1, false, false); \
    u32x4 w = {r0[0], r1[0], r0[1], r1[1]}; OUT = *reinterpret_cast<bf16x8*>(&w); } while (0)
  PK4(p0, 0, pa0); PK4(p0, 8, pa1); PK4(p1, 0, pa2); PK4(p1, 8, pa3);
#undef PK4
}
__device__ __forceinline__ void qkt(f32x16& p0, f32x16& p1, const bf16* Ks, const bf16x8* qr, int r32, int hi) {
  p0 = f32x16{}; p1 = f32x16{};
  for (int d0 = 0; d0 < 8; ++d0) { int cb = (d0 * 16 + hi * 8) * 2;
    bf16x8 b0 = *reinterpret_cast<const bf16x8*>((const char*)Ks + KSWZ(r32, cb));
    bf16x8 b1 = *reinterpret_cast<const bf16x8*>((const char*)Ks + KSWZ(32 + r32, cb));
    p0 = __builtin_amdgcn_mfma_f32_32x32x16_bf16(b0, qr[d0], p0, 0, 0, 0);
    p1 = __builtin_amdgcn_mfma_f32_32x32x16_bf16(b1, qr[d0], p1, 0, 0, 0); }
}
__device__ __forceinline__ int v_st(int k, int c) { const int kk = (k & ~0xC) | ((k & 4) << 1) | ((k & 8) >> 1); return ((kk >> 3) * 4 + (c >> 5)) * 512 + ((kk & 7) * 32 + (c & 31)) * 2; }
__device__ __forceinline__ int v_rd_base(int lane) { return ((lane & 3) << 3) | (((lane >> 2) & 3) << 6) | (((lane >> 4) & 1) << 5) | (((lane >> 5) & 1) << 8); }
constexpr int v_rd_off(int d0, int ks, int half) { return d0 * 512 + ks * 4096 + half * 2048; }
template <int OFF> __device__ __forceinline__ s16x4 tr_read(int vb) {
  s16x4 r; asm volatile("ds_read_b64_tr_b16 %0, %1 offset:%2" : "=&v"(r) : "v"(vb), "i"(OFF) : "memory"); return r;
}
template <int D0> __device__ __forceinline__ void pv_one(f32x16& od, int vb, bf16x8 pa0, bf16x8 pa1, bf16x8 pa2, bf16x8 pa3) {
  const s16x4 l0 = tr_read<v_rd_off(D0, 0, 0)>(vb), h0 = tr_read<v_rd_off(D0, 0, 1)>(vb), l1 = tr_read<v_rd_off(D0, 1, 0)>(vb), h1 = tr_read<v_rd_off(D0, 1, 1)>(vb);
  const s16x4 l2 = tr_read<v_rd_off(D0, 2, 0)>(vb), h2 = tr_read<v_rd_off(D0, 2, 1)>(vb), l3 = tr_read<v_rd_off(D0, 3, 0)>(vb), h3 = tr_read<v_rd_off(D0, 3, 1)>(vb);
  asm volatile("s_waitcnt lgkmcnt(0)" ::: "memory"); SBAR();
#define PK(L, H) (bf16x8){L[0], L[1], L[2], L[3], H[0], H[1], H[2], H[3]}
  od = __builtin_amdgcn_mfma_f32_32x32x16_bf16(pa0, PK(l0, h0), od, 0, 0, 0);
  od = __builtin_amdgcn_mfma_f32_32x32x16_bf16(pa1, PK(l1, h1), od, 0, 0, 0);
  od = __builtin_amdgcn_mfma_f32_32x32x16_bf16(pa2, PK(l2, h2), od, 0, 0, 0);
  od = __builtin_amdgcn_mfma_f32_32x32x16_bf16(pa3, PK(l3, h3), od, 0, 0, 0);
#undef PK
}
__device__ __forceinline__ void pv_d0(f32x16* o, int vb, bf16x8 pa0, bf16x8 pa1, bf16x8 pa2, bf16x8 pa3) {
  pv_one<0>(o[0], vb, pa0, pa1, pa2, pa3); pv_one<1>(o[1], vb, pa0, pa1, pa2, pa3); pv_one<2>(o[2], vb, pa0, pa1, pa2, pa3); pv_one<3>(o[3], vb, pa0, pa1, pa2, pa3);
}
template <typename TQ>
__device__ __forceinline__ void attn_dense_body(const TQ* __restrict__ Qb, const bf16* __restrict__ Kh, const bf16* __restrict__ Vh,
                                                bf16* __restrict__ Ob, int seq, char* lds) {
  using St = Stage<bf16>; using SQ = Stage<TQ>;
  const int tid = otid(), wid = tid >> 6, lane = tid & 63, r32 = lane & 31, hi = lane >> 5;
  bf16* V_lds = (bf16*)lds; bf16* K_lds = (bf16*)(lds + 2 * SHM_V);
  float* ws = (float*)(lds + 2 * SHM_V + 2 * SHM_K) + wid * 64; float* li_l = ws; float* al_l = ws + 32;
  float m_reg = -1e30f, l_reg = 0; f32x16 o[4] = {}; bf16x8 qr[8];
  const TQ* Qw = Qb + (long)(wid * QBLK + r32) * LDQ + hi * 8;
#pragma unroll
  for (int d0 = 0; d0 < 8; ++d0) qr[d0] = SQ::tobf(SQ::ld8(Qw + d0 * 16));
  const int sr = tid >> 4, sc = (tid & 15) * 8, vst0 = v_st(sr, sc), vst1 = v_st(32 + sr, sc);
  const int vb0 = (int)(uintptr_t)V_lds + v_rd_base(lane);
  struct { typename St::T vs0, vs1, ks0, ks1; } sr_[SDEPTH];
#define SLOAD(i, k0) do { sr_[i].vs0 = St::ld8(&Vh[(long)((k0) + sr) * LDK + sc]); sr_[i].vs1 = St::ld8(&Vh[(long)((k0) + 32 + sr) * LDK + sc]); \
    sr_[i].ks0 = St::ld8(&Kh[(long)((k0) + sr) * LDK + sc]); sr_[i].ks1 = St::ld8(&Kh[(long)((k0) + 32 + sr) * LDK + sc]); } while (0)
#define SWRITE(b, i) do { *(bf16x8*)((char*)V_lds + (b) * SHM_V + vst0) = St::tobf(sr_[i].vs0);          \
    *(bf16x8*)((char*)V_lds + (b) * SHM_V + vst1) = St::tobf(sr_[i].vs1); int kc = sc * 2;               \
    *(bf16x8*)((char*)K_lds + (b) * SHM_K + KSWZ(sr, kc)) = St::tobf(sr_[i].ks0);                       \
    *(bf16x8*)((char*)K_lds + (b) * SHM_K + KSWZ(32 + sr, kc)) = St::tobf(sr_[i].ks1); } while (0)
#define SWAIT() do { if constexpr (SDEPTH == 2) asm volatile("s_waitcnt vmcnt(4)" ::: "memory"); else asm volatile("s_waitcnt vmcnt(0)" ::: "memory"); } while (0)
#define RESC(a) do { if (__any((a) < 1.f)) { if (hi == 0) al_l[r32] = (a); asm volatile("s_waitcnt lgkmcnt(0)" ::: "memory"); \
    for (int d = 0; d < 4; ++d) for (int r = 0; r < 16; ++r) o[d][r] *= al_l[crow(r, hi)]; } } while (0)
  f32x16 pA0, pA1, pB0, pB1; float mnA, mnB, alA, alB; bf16x8 pa0, pa1, pa2, pa3; const int NT = seq / KVBLK;
  constexpr int SE = 0, SO = SDEPTH - 1;
  SLOAD(SE, 0); asm volatile("s_waitcnt vmcnt(0)" ::: "memory"); SWRITE(0, SE); __syncthreads();
  qkt(pA0, pA1, K_lds, qr, r32, hi); partialSM(pA0, pA1, m_reg, mnA, alA);
  SLOAD(SO, KVBLK); if constexpr (SDEPTH == 2) { if (2 < NT) SLOAD(SE, 2 * KVBLK); }
  SWAIT(); SWRITE(1, SO); __syncthreads();
  for (int j = 1; j + 1 < NT; j += 2) {
    SBAR(); qkt(pB0, pB1, (bf16*)((char*)K_lds + SHM_K), qr, r32, hi);
    finishSM(pA0, pA1, alA, l_reg, pa0, pa1, pa2, pa3); SBAR();
    SLOAD(SO, (j + SDEPTH) * KVBLK); SBAR();
    pv_d0(o, vb0, pa0, pa1, pa2, pa3); partialSM(pB0, pB1, m_reg, mnB, alB);
    __syncthreads(); SWAIT(); SWRITE(0, SE);
    RESC(alB); __syncthreads();
    SBAR(); qkt(pA0, pA1, K_lds, qr, r32, hi);
    finishSM(pB0, pB1, alB, l_reg, pa0, pa1, pa2, pa3); SBAR();
    if (SDEPTH == 1 || j + 3 < NT) SLOAD(SE, (j + 1 + SDEPTH) * KVBLK); SBAR();
    pv_d0(o, vb0 + (int)SHM_V, pa0, pa1, pa2, pa3); partialSM(pA0, pA1, m_reg, mnA, alA);
    __syncthreads(); SWAIT(); SWRITE(1, SO);
    RESC(alA); __syncthreads();
  }
  SBAR(); qkt(pB0, pB1, (bf16*)((char*)K_lds + SHM_K), qr, r32, hi);
  finishSM(pA0, pA1, alA, l_reg, pa0, pa1, pa2, pa3); SBAR();
  pv_d0(o, vb0, pa0, pa1, pa2, pa3); partialSM(pB0, pB1, m_reg, mnB, alB);
  __syncthreads(); RESC(alB);
  finishSM(pB0, pB1, alB, l_reg, pa0, pa1, pa2, pa3); SBAR();
  pv_d0(o, vb0 + (int)SHM_V, pa0, pa1, pa2, pa3);
  if (hi == 0) li_l[r32] = l_reg; asm volatile("s_waitcnt lgkmcnt(0)" ::: "memory");
  float rli[16];
#pragma unroll
  for (int r = 0; r < 16; ++r) rli[r] = __builtin_amdgcn_rcpf(li_l[crow(r, hi)]);
  bf16* Ow = Ob + (long)(wid * QBLK) * LDO;
#pragma unroll
  for (int r = 0; r < 16; ++r) { int orow = crow(r, hi);
    for (int d0 = 0; d0 < 4; ++d0) Ow[(long)orow * LDO + d0 * 32 + r32] = (bf16)f2bf(o[d0][r] * rli[r]); }
#undef SLOAD
#undef SWRITE
#undef SWAIT
#undef RESC
}
}
typedef unsigned short bf16_t;
typedef short bf16x8 __attribute__((ext_vector_type(8)));
#define MFMA16(a, b, c) __builtin_amdgcn_mfma_f32_16x16x32_bf16((a), (b), (c), 0, 0, 0)

struct Params { const float* in[30]; float* out; unsigned char* ws; int lo, hi; };

__device__ __forceinline__ void phase_mod_filters(const Params& p, unsigned char* smem, int bid, int G, int tid, int wid, int lane) {
    float* sc = (float*)smem;
    float* red = sc + 9 * 1024;
    float* modv = (float*)(p.ws + WS_MODV);
    const float* c = p.in[1]; const float* cctx = p.in[3]; const float* ada_w = p.in[4]; const float* ada_b = p.in[5];
    for (int i = tid; i < 9 * 1024; i += 512) { const int b = i >> 10, k = i & 1023; const float v = b < 8 ? c[b * 1024 + k] : cctx[k]; sc[i] = v / (1.f + __expf(-v)); }
    __syncthreads();
    for (int it = bid; it < 576; it += G) {
        const int l = it / 144, n0 = (it % 144) * 64;
        const float* W = ada_w + (size_t)l * 1024 * NMODC + n0 + lane;
        float acc[9];
#pragma unroll
        for (int b = 0; b < 9; ++b) acc[b] = 0.f;
        const int k0 = wid * 128;
#pragma unroll 8
        for (int k = 0; k < 128; ++k) {
            const float wv = W[(size_t)(k0 + k) * NMODC];
#pragma unroll
            for (int b = 0; b < 9; ++b) acc[b] += sc[b * 1024 + k0 + k] * wv;
        }
#pragma unroll
        for (int b = 0; b < 9; ++b) red[(wid * 9 + b) * 64 + lane] = acc[b];
        __syncthreads();
        for (int i = tid; i < 576; i += 512) {
            const int b = i >> 6, j = i & 63; float s = ada_b[l * NMODC + n0 + j];
#pragma unroll
            for (int w = 0; w < 8; ++w) s += red[(w * 9 + b) * 64 + j];
            modv[(size_t)(l * 9 + b) * NMODC + n0 + j] = s;
        }
        __syncthreads();
    }
    const int gw = bid * 8 + wid, NGW = G * 8;
    const float mind = -3.0701134573253943f, maxd = -15.350567286626972f;
    for (int it = gw; it < 1152; it += NGW) {
        const int e = it / 576, r = it % 576; const int set = r >= 512; const int L = set ? 256 : 2048; const int n0 = (set ? r - 512 : r) * 4;
        const float* w1 = p.in[14] + e * 33 * 64; const float* b1 = p.in[15] + e * 64; const float* fr1 = p.in[16] + e * 64;
        const float* w2 = p.in[17] + e * 64 * 64; const float* b2 = p.in[18] + e * 64; const float* fr2 = p.in[19] + e * 64;
        const float* w3 = p.in[20] + (size_t)e * 64 * 1024; const float* b3 = p.in[21] + e * 1024;
        float* KF = set ? (float*)(p.ws + WS_KFC) + (size_t)e * 2 * 512 * 256 : (float*)(p.ws + WS_KFL) + (size_t)e * 2 * 512 * 2048;
        float h2[4];
#pragma unroll
        for (int q = 0; q < 4; ++q) {
            const int n = n0 + q; const float tt = (float)n / (float)(L - 1);
            float feat = 0.f;
            if (lane == 0) feat = tt;
            else if (lane < 33) { const int bi = (lane - 1) & 15; const float band = 1e-4f + (float)bi * ((15.f - 1e-4f) / 15.f);
                const float ang = ((6.283185307179586f * (float)n) * band) / (float)L; feat = lane < 17 ? cosf(ang) : -sinf(ang); }
            float a1 = b1[lane];
            for (int i = 0; i < 33; ++i) a1 += __shfl(feat, i) * w1[i * 64 + lane];
            const float h1 = sinf(fr1[lane] * a1);
            float a2 = b2[lane];
            for (int j = 0; j < 64; ++j) a2 += __shfl(h1, j) * w2[j * 64 + lane];
            h2[q] = sinf(fr2[lane] * a2);
        }
        for (int m = 0; m < 16; ++m) {
            const int col = m * 64 + lane; float acc[4];
#pragma unroll
            for (int q = 0; q < 4; ++q) acc[q] = b3[col];
            for (int j = 0; j < 64; ++j) { const float wv = w3[j * 1024 + col];
#pragma unroll
                for (int q = 0; q < 4; ++q) acc[q] += __shfl(h2[q], j) * wv; }
            const int dir = col >> 9, w = col & 511;
            const float delta = fabsf(mind + (float)w * ((maxd - mind) / 511.f));
            f32x4 o;
#pragma unroll
            for (int q = 0; q < 4; ++q) { const float tt = (float)(n0 + q) / (float)(L - 1); o[q] = acc[q] * __expf(-tt * delta); }
            *(f32x4*)(KF + (size_t)(dir * 512 + w) * L + n0) = o;
        }
    }
}

__device__ __forceinline__ void transpose_item(const float* W, int K, int N, bf16_t* WT, int mode, float* scr, int item, int lane) {
    const int nblk = N / 32, kb = item / nblk, nb = item % nblk, k0 = 64 * kb, n0 = 32 * nb;
#pragma unroll 8
    for (int i = 0; i < 32; ++i) { const int kk = 2 * i + (lane >> 5); scr[kk * 33 + (lane & 31)] = W[(size_t)(k0 + kk) * N + n0 + (lane & 31)]; }
    LDS_WAIT(); asm volatile("" ::: "memory");
    const int c = lane & 7;
#pragma unroll
    for (int j = 0; j < 4; ++j) { const int n = (lane >> 3) + 8 * j; const float* s = scr + (8 * c) * 33 + n;
        u32x4 o; o.x = pk2(s[0 * 33], s[1 * 33]); o.y = pk2(s[2 * 33], s[3 * 33]); o.z = pk2(s[4 * 33], s[5 * 33]); o.w = pk2(s[6 * 33], s[7 * 33]);
        int dn = n0 + n;
        if (mode == 1) { const int half = dn >= FH ? 1 : 0; const int jj = dn - half * FH; dn = (jj >> 7) * 256 + half * 128 + (jj & 127); }
        *(u32x4*)(WT + (size_t)dn * K + k0 + 8 * c) = o; }
    LDS_WAIT(); asm volatile("" ::: "memory");
}
__device__ __forceinline__ void phase_convert_init(const Params& p, unsigned char* smem, int bid, int G, int tid, int wid, int lane) {
    float* scr = (float*)(smem + wid * 8448);
    const int gw = bid * 8 + wid, NGW = G * 8;
    for (int it = gw; it < 40480; it += NGW) {
        int r = it; const float* W; bf16_t* WT; int K, N, mode = 0;
        if (r < 22528) { const int m = r / 2816; r %= 2816; W = p.in[8] + (size_t)m * 1024 * 5632; WT = (bf16_t*)(p.ws + WS_WT1) + (size_t)m * 5632 * 1024; K = 1024; N = 5632; mode = 1; }
        else if ((r -= 22528) < 11264) { const int m = r / 1408; r %= 1408; W = p.in[9] + (size_t)m * 2816 * 1024; WT = (bf16_t*)(p.ws + WS_WT2) + (size_t)m * 1024 * 2816; K = 2816; N = 1024; }
        else if ((r -= 11264) < 3104) { const int m = r / 1552; r %= 1552; W = p.in[10] + (size_t)m * 1024 * EIN; WT = (bf16_t*)(p.ws + WS_WEI) + (size_t)m * EINP * 1024; K = 1024; N = EIN; }
        else if ((r -= 3104) < 1024) { const int m = r / 512; r %= 512; W = p.in[11] + (size_t)m * 1024 * 1024; WT = (bf16_t*)(p.ws + WS_WEO) + (size_t)m * 1024 * 1024; K = 1024; N = 1024; }
        else if ((r -= 1024) < 1536) { const int m = r / 768; r %= 768; W = p.in[26] + (size_t)m * 1024 * OIN; WT = (bf16_t*)(p.ws + WS_WAI) + (size_t)m * OIN * 1024; K = 1024; N = OIN; }
        else { r -= 1536; const int m = r / 512; r %= 512; W = p.in[27] + (size_t)m * 1024 * 1024; WT = (bf16_t*)(p.ws + WS_WAO) + (size_t)m * 1024 * 1024; K = 1024; N = 1024; }
        transpose_item(W, K, N, WT, mode, scr, r, lane);
    }
    for (int i = bid * 512 + tid; i < 2 * 224 * 128; i += G * 512) { const int m = i / (224 * 128), j = i % (224 * 128);
        *(u32x4*)((bf16_t*)(p.ws + WS_WEI) + (size_t)m * EINP * 1024 + (size_t)EIN * 1024 + (size_t)j * 8) = (u32x4){0u, 0u, 0u, 0u}; }
    const float* modv = (const float*)(p.ws + WS_MODV);
    float* H = (float*)(p.ws + WS_H); bf16_t* A = (bf16_t*)(p.ws + WS_A);
    for (int r = gw; r < R_ALL; r += NGW) {
        const float* src = r < R_LAT ? p.in[0] + (size_t)r * DM : p.in[2] + (size_t)(r - R_LAT) * DM;
        const int b = r < R_LAT ? (r >> 11) : 8;
        const float* sh = modv + (size_t)b * NMODC; const float* scl = sh + 1024;
#pragma unroll
        for (int j = 0; j < 4; ++j) { const int col = 4 * lane + 256 * j;
            const f32x4 v = *(const f32x4*)(src + col); const f32x4 s = *(const f32x4*)(sh + col), q = *(const f32x4*)(scl + col);
            *(f32x4*)(H + (size_t)r * DM + col) = v;
            const f32x4 a = v * (1.f + q) + s;
            u32x2 w; w.x = pk2(a[0], a[1]); w.y = pk2(a[2], a[3]); *(u32x2*)(A + (size_t)r * DM + col) = w; }
    }
}

__device__ __forceinline__ void phase_ln(const Params& p, int sl, int nrows, int bid, int G, int wid, int lane) {
    const int gw = bid * 8 + wid, NGW = G * 8;
    const float* g = p.in[6] + (size_t)sl * DM; const float* bt = p.in[7] + (size_t)sl * DM;
    const bool last = sl == 11;
    const int sn = sl + 1, ln_ = sn / 3, slotn = sn % 3;
    const float* modn = (const float*)(p.ws + WS_MODV) + (size_t)(last ? 0 : ln_) * 9 * NMODC + (size_t)(3 * (last ? 0 : slotn)) * 1024;
    float* H = (float*)(p.ws + WS_H); bf16_t* A = (bf16_t*)(p.ws + WS_A);
    for (int r = gw; r < nrows; r += NGW) {
        float* hr = H + (size_t)r * DM; f32x4 v[4]; float s = 0.f;
#pragma unroll
        for (int j = 0; j < 4; ++j) { v[j] = *(const f32x4*)(hr + 4 * lane + 256 * j); s += (v[j][0] + v[j][1]) + (v[j][2] + v[j][3]); }
        const float mean = wave_sum(s) * (1.f / DM); float s2 = 0.f;
#pragma unroll
        for (int j = 0; j < 4; ++j) { v[j] = v[j] - mean; s2 += (v[j][0] * v[j][0] + v[j][1] * v[j][1]) + (v[j][2] * v[j][2] + v[j][3] * v[j][3]); }
        const float rstd = rsqrtf(wave_sum(s2) * (1.f / DM) + LN_EPS);
        const int b = r < R_LAT ? (r >> 11) : 8;
        const float* sh = modn + (size_t)b * NMODC; const float* scl = sh + 1024;
#pragma unroll
        for (int j = 0; j < 4; ++j) { const int col = 4 * lane + 256 * j;
            const f32x4 hv = v[j] * rstd * *(const f32x4*)(g + col) + *(const f32x4*)(bt + col);
            if (last) { *(f32x4*)(p.out + (size_t)r * DM + col) = hv; }
            else { *(f32x4*)(hr + col) = hv;
                const f32x4 a = hv * (1.f + *(const f32x4*)(scl + col)) + *(const f32x4*)(sh + col);
                u32x2 w; w.x = pk2(a[0], a[1]); w.y = pk2(a[2], a[3]); *(u32x2*)(A + (size_t)r * DM + col) = w; }
        }
    }
}

__device__ __forceinline__ void phase_normrope(const Params& p, int o, int bid, int G, int wid, int lane) {
    const int gw = bid * 8 + wid, NGW = G * 8;
    const bf16_t* PROJ = (const bf16_t*)(p.ws + WS_PROJ); bf16_t* QB = (bf16_t*)(p.ws + WS_QB); bf16_t* KB = (bf16_t*)(p.ws + WS_KB); bf16_t* VB = (bf16_t*)(p.ws + WS_VB);
    const float* qn = p.in[28] + o * 128; const float* kn = p.in[29] + o * 128;
    const int half = lane >> 5, pp = lane & 31;
    const float invf = powf(10000.f, -(float)pp / 32.f);
    const int i1 = half * 64 + pp, i2 = i1 + 32;
    const float gq1 = qn[i1], gq2 = qn[i2], gk1 = kn[i1], gk2 = kn[i2];
    for (int r = gw; r < R_ALL; r += NGW) {
        const bf16_t* pr = PROJ + (size_t)r * OIN;
        const bool lat = r < R_LAT; const int b = lat ? (r >> 11) : ((r - R_LAT) >> 8); const int t = lat ? (r & 2047) : ((r - R_LAT) & 255);
        float cs = 1.f, sn = 0.f;
        if (lat) { const float pos = (float)(half ? (t & 63) : (t >> 6)); const float ang = pos * invf; cs = cosf(ang); sn = sinf(ang); }
        const int kpos = lat ? t : 2048 + t;
#pragma unroll
        for (int hh = 0; hh < 10; ++hh) {
            const int base = hh < 8 ? hh * 128 : 1024 + (hh - 8) * 128;
            float x1 = bf2f(pr[base + i1]), x2 = bf2f(pr[base + i2]);
            const float ss = wave_sum(x1 * x1 + x2 * x2);
            const float rstd = rsqrtf(ss * (1.f / 128.f) + RMS_EPS);
            x1 *= rstd * (hh < 8 ? gq1 : gk1); x2 *= rstd * (hh < 8 ? gq2 : gk2);
            const float y1 = x1 * cs - x2 * sn, y2 = x2 * cs + x1 * sn;
            bf16_t* dst = hh < 8 ? QB + (size_t)r * 1024 + hh * 128 : KB + ((size_t)(b * 2 + (hh - 8)) * 2304 + kpos) * 128;
            dst[i1] = (bf16_t)f2bf(y1); dst[i2] = (bf16_t)f2bf(y2);
        }
#pragma unroll
        for (int kv = 0; kv < 2; ++kv)
            *(unsigned*)(VB + ((size_t)(b * 2 + kv) * 2304 + kpos) * 128 + 2 * lane) = *(const unsigned*)(pr + 1280 + kv * 128 + 2 * lane);
    }
}

__device__ __forceinline__ void phase_attn(const Params& p, bool need_ctx, unsigned char* smem, int bid, int G) {
    const bf16_t* QB = (const bf16_t*)(p.ws + WS_QB); const bf16_t* KB = (const bf16_t*)(p.ws + WS_KB); const bf16_t* VB = (const bf16_t*)(p.ws + WS_VB);
    bf16_t* MIX = (bf16_t*)(p.ws + WS_MIX);
    const int nunits = 512 + (need_ctx ? 64 : 0);
    for (int u = bid; u < nunits; u += G) {
        size_t qoff, koff; int seq;
        if (u < 512) { const int b = u >> 6, h = (u >> 3) & 7, qb = u & 7; qoff = ((size_t)(b * 2048 + qb * 256)) * 1024 + h * 128; koff = (size_t)(b * 2 + (h >> 2)) * 2304 * 128; seq = 2304; }
        else { const int v = u - 512, b = v >> 3, h = v & 7; qoff = ((size_t)(R_LAT + b * 256)) * 1024 + h * 128; koff = ((size_t)(b * 2 + (h >> 2)) * 2304 + 2048) * 128; seq = 256; }
        attn::attn_dense_body<attn::bf16>(QB + qoff, KB + koff, VB + koff, MIX + qoff, seq, (char*)smem);
        __syncthreads();
    }
}

__device__ __forceinline__ void hy_decode(int u, int& set, int& b, int& t0, int& ct, int& L, int& rowbase) {
    set = u >= 2048; int v = set ? u - 2048 : u; ct = v & 7; v >>= 3;
    if (!set) { t0 = (v & 31) * 64; b = v >> 5; L = 2048; rowbase = b * 2048; } else { t0 = (v & 3) * 64; b = v >> 2; L = 256; rowbase = R_LAT + b * 256; }
}
__device__ __forceinline__ void phase_shortconv(const Params& p, int e, unsigned char* smem, int bid, int G, int tid) {
    const bf16_t* PROJ = (const bf16_t*)(p.ws + WS_PROJ); bf16_t* P2 = (bf16_t*)(p.ws + WS_P2);
    const float* cw = p.in[12] + (size_t)e * 3 * 1536; const float* cb = p.in[13] + (size_t)e * 1536;
    bf16_t* zl = (bf16_t*)smem;
    for (int u = bid; u < 2304; u += G) {
        int set, b, t0, ct, L, rowbase; hy_decode(u, set, b, t0, ct, L, rowbase);
        bf16_t* ZT = set ? (bf16_t*)(p.ws + WS_ZTC) : (bf16_t*)(p.ws + WS_ZTL);
        const bf16_t* pr = PROJ + (size_t)rowbase * EINP;
        const int cl = tid & 63, tr = tid >> 6, c = ct * 64 + cl;
        float w[3][3], bb[3];
#pragma unroll
        for (int pt = 0; pt < 3; ++pt) {
#pragma unroll
            for (int k = 0; k < 3; ++k) w[pt][k] = cw[k * 1536 + pt * 512 + c];
            bb[pt] = cb[pt * 512 + c]; }
        float uu[3][10];
#pragma unroll
        for (int k = 0; k < 10; ++k) { const int t = t0 + tr * 8 + k - 1; const bool ok = t >= 0 && t < L;
#pragma unroll
            for (int pt = 0; pt < 3; ++pt) uu[pt][k] = ok ? bf2f(pr[(size_t)t * EINP + pt * 512 + c]) : 0.f; }
#pragma unroll
        for (int i = 0; i < 8; ++i) { float pv[3];
#pragma unroll
            for (int pt = 0; pt < 3; ++pt) pv[pt] = uu[pt][i] * w[pt][0] + uu[pt][i + 1] * w[pt][1] + uu[pt][i + 2] * w[pt][2] + bb[pt];
            zl[cl * 72 + tr * 8 + i] = (bf16_t)f2bf(pv[0] * pv[1]);
            P2[(size_t)(rowbase + t0 + tr * 8 + i) * 512 + c] = (bf16_t)f2bf(pv[2]); }
        __syncthreads();
        { const int cc = tid >> 3, part = tid & 7;
          *(u32x4*)(ZT + ((size_t)(ct * 64 + cc) * 8 + b) * L + t0 + part * 8) = *(const u32x4*)(zl + cc * 72 + part * 8); }
        __syncthreads();
    }
}
__device__ __forceinline__ void phase_hyena_fin(const Params& p, unsigned char* smem, int bid, int G, int tid) {
    const bf16_t* P2 = (const bf16_t*)(p.ws + WS_P2); bf16_t* MIX = (bf16_t*)(p.ws + WS_MIX);
    bf16_t* zl = (bf16_t*)smem;
    for (int u = bid; u < 2304; u += G) {
        int set, b, t0, ct, L, rowbase; hy_decode(u, set, b, t0, ct, L, rowbase);
        const bf16_t* ZT = set ? (const bf16_t*)(p.ws + WS_ZTC) : (const bf16_t*)(p.ws + WS_ZTL);
        { const int cc = tid >> 3, part = tid & 7;
          *(u32x4*)(zl + cc * 72 + part * 8) = *(const u32x4*)(ZT + ((size_t)(ct * 64 + cc) * 8 + b) * L + t0 + part * 8); }
        __syncthreads();
        const int cl = tid & 63, tr = tid >> 6, c = ct * 64 + cl;
#pragma unroll
        for (int i = 0; i < 8; ++i) { const int t = t0 + tr * 8 + i;
            const float y = bf2f(zl[cl * 72 + tr * 8 + i]), p2 = bf2f(P2[(size_t)(rowbase + t) * 512 + c]);
            MIX[(size_t)(rowbase + t) * 1024 + c] = (bf16_t)f2bf(y * p2); }
        __syncthreads();
    }
}

__device__ __forceinline__ void toeplitz_unit(unsigned char* smem, const float* kf_f, const float* kf_b, bf16_t* zt, float skip, int L, int tid, int wid, int lane) {
    const int CP = 2 * L + 8;
    bf16_t* Gc = (bf16_t*)smem;
    bf16_t* zs = (bf16_t*)(smem + (size_t)8 * CP * 2);
    float* red = (float*)(smem + (size_t)8 * CP * 2 + (size_t)8 * L * 2);
    float ss = 0.f;
    for (int i = tid; i < L; i += 512) { const float a = kf_f[i]; ss += a * a; if (i >= 1) { const float b = kf_b[i]; ss += b * b; } }
    ss = wave_sum(ss); if (lane == 0) red[wid] = ss;
    for (int i = tid; i < L; i += 512) ((u32x4*)zs)[i] = ((const u32x4*)zt)[i];
    __syncthreads();
    float tot = 0.f;
#pragma unroll
    for (int w = 0; w < 8; ++w) tot += red[w];
    const float nrm = rsqrtf(tot + 1e-6f);
    for (int pidx = tid; pidx < CP; pidx += 512) {
#pragma unroll
        for (int m = 0; m < 8; ++m) { const int x = pidx - m; float v = 0.f;
            if (x >= 1 && x <= L) v = kf_f[L - x]; else if (x > L && x <= 2 * L - 1) v = kf_b[x - L];
            Gc[m * CP + pidx] = (bf16_t)f2bf(v * nrm); }
    }
    __syncthreads();
    const int row = lane & 15, kg = lane >> 4;
    const int nJ = L / 32, tbw = (L / 16) / 8;
    const bf16_t* Gm = Gc + (row & 7) * CP;
    const bf16_t* zb = zs + (row & 7) * L + kg * 8;
    for (int g = 0; g < tbw; g += 2) {
        const int I0 = wid * tbw + g;
        f32x4 acc0 = {0.f, 0.f, 0.f, 0.f}, acc1 = {0.f, 0.f, 0.f, 0.f};
        const bf16_t* pa0 = Gm + (L - 16 * I0 + kg * 8 - (row & 8)); const bf16_t* pa1 = pa0 - 16;
        for (int J = 0; J < nJ; ++J) {
            const bf16x8 bz = *(const bf16x8*)(zb + 32 * J);
            const bf16x8 a0 = *(const bf16x8*)(pa0 + 32 * J);
            const bf16x8 a1 = *(const bf16x8*)(pa1 + 32 * J);
            acc0 = MFMA16(a0, bz, acc0); acc1 = MFMA16(a1, bz, acc1);
        }
        if (row < 8) {
#pragma unroll
            for (int q = 0; q < 2; ++q) { const f32x4 a = q ? acc1 : acc0; const int t = 16 * (I0 + q) + kg * 4;
                const bf16_t* zz = zs + row * L + t;
                u32x2 w; w.x = pk2(a[0] + bf2f(zz[0]) * skip, a[1] + bf2f(zz[1]) * skip); w.y = pk2(a[2] + bf2f(zz[2]) * skip, a[3] + bf2f(zz[3]) * skip);
                *(u32x2*)(zt + (size_t)row * L + t) = w; }
        }
    }
    __syncthreads();
}

constexpr int GL_LO = 0, GL_TOT = 8192, GL_BLAST = 10240, GL_QI = 10752, GL_KI = GL_QI + 18432, GL_KT = GL_KI + 18432, GL_VT = GL_KT + 18432, GL_ATT = GL_VT + 18432, GL_SSQ = GL_ATT + 18432;
template <bool DS>
__device__ __forceinline__ void gla_stage(unsigned char* smem, const bf16_t* PROJ, const float* GLO, const float* gate_up, const float* gate_b, int rowbase, int h, int tid) {
    float* lo_s = (float*)(smem + GL_LO); float* tot = (float*)(smem + GL_TOT); float* blast = (float*)(smem + GL_BLAST);
    bf16_t* qi = (bf16_t*)(smem + GL_QI); bf16_t* ki = (bf16_t*)(smem + GL_KI); bf16_t* kT = (bf16_t*)(smem + GL_KT); bf16_t* vT = (bf16_t*)(smem + GL_VT);
    ((f32x4*)lo_s)[tid] = ((const f32x4*)(GLO + (size_t)rowbase * 32))[tid];
    { const int dv = tid & 127, tg = tid >> 7;
#pragma unroll 4
      for (int i = 0; i < 16; ++i) { const int tok = tg * 16 + i; vT[dv * 72 + tok] = PROJ[(size_t)(rowbase + tok) * EINP + 2048 + h * 128 + dv]; } }
    __syncthreads();
    const int d = tid & 63, dir = (tid >> 6) & 1, qtr = tid >> 7;
    float gu[16];
#pragma unroll
    for (int r = 0; r < 16; ++r) gu[r] = gate_up[(dir * 16 + r) * 256 + h * 64 + d];
    const float gb = gate_b[dir * 256 + h * 64 + d];
    float lg[16];
#pragma unroll
    for (int i = 0; i < 16; ++i) { const int tok = qtr * 16 + i; float x = gb;
#pragma unroll
        for (int r = 0; r < 16; ++r) x += lo_s[tok * 32 + dir * 16 + r] * gu[r];
        lg[i] = (fminf(x, 0.f) - log1pf(__expf(-fabsf(x)))) * (1.f / 16.f); }
    float total;
    if (dir == 0) {
#pragma unroll
        for (int i = 1; i < 16; ++i) lg[i] += lg[i - 1];
        total = lg[15];
    } else {
#pragma unroll
        for (int i = 14; i >= 0; --i) lg[i] += lg[i + 1];
        total = lg[0];
    }
    tot[(dir * 4 + qtr) * 64 + d] = total;
    __syncthreads();
    float off = 0.f, all = 0.f;
#pragma unroll
    for (int q = 0; q < 4; ++q) { const float tq = tot[(dir * 4 + q) * 64 + d]; all += tq; if (dir == 0 ? (q < qtr) : (q > qtr)) off += tq; }
    if (qtr == 0) blast[dir * 64 + d] = all;
#pragma unroll
    for (int i = 0; i < 16; ++i) { const int tok = qtr * 16 + i; const float bb = off + lg[i];
        const float kin = bf2f(PROJ[(size_t)(rowbase + tok) * EINP + 1792 + h * 64 + d]) * __expf(-bb);
        if (DS) kT[(dir * 64 + d) * 72 + tok] = (bf16_t)f2bf(kin);
        else { ki[(dir * 64 + tok) * 72 + d] = (bf16_t)f2bf(kin);
            const float qin = bf2f(PROJ[(size_t)(rowbase + tok) * EINP + 1536 + h * 64 + d]) * 0.125f * __expf(bb);
            qi[(dir * 64 + tok) * 72 + d] = (bf16_t)f2bf(qin); } }
    __syncthreads();
}
__device__ __forceinline__ void gla_decode(int u, int& b, int& gc, int& h, int& rowbase) {
    h = u & 3; const int v = u >> 2; gc = v % 36; b = v / 36;
    rowbase = gc < 4 ? R_LAT + b * 256 + gc * 64 : b * 2048 + (gc - 4) * 64;
}
__device__ __forceinline__ void phase_gla_ds(const Params& p, int e, unsigned char* smem, int bid, int G, int tid, int wid, int lane) {
    const bf16_t* PROJ = (const bf16_t*)(p.ws + WS_PROJ); const float* GLO = (const float*)(p.ws + WS_GLO);
    float* DSb = (float*)(p.ws + WS_DS); float* DEC = (float*)(p.ws + WS_DEC);
    const float* gup = p.in[23] + (size_t)e * 2 * 16 * 256; const float* gbb = p.in[24] + (size_t)e * 2 * 256;
    const bf16_t* kT = (const bf16_t*)(smem + GL_KT); const bf16_t* vT = (const bf16_t*)(smem + GL_VT); const float* blast = (const float*)(smem + GL_BLAST);
    const int row = lane & 15, kg = lane >> 4;
    for (int u = bid; u < 1152; u += G) {
        int b, gc, h, rowbase; gla_decode(u, b, gc, h, rowbase);
        gla_stage<true>(smem, PROJ, GLO, gup, gbb, rowbase, h, tid);
        const int dir = wid >> 2, dkb = wid & 3;
        bf16x8 a[2];
#pragma unroll
        for (int ks = 0; ks < 2; ++ks) a[ks] = *(const bf16x8*)(kT + (dir * 64 + dkb * 16 + row) * 72 + ks * 32 + kg * 8);
        float eb[4];
#pragma unroll
        for (int i = 0; i < 4; ++i) eb[i] = __expf(blast[dir * 64 + dkb * 16 + kg * 4 + i]);
        const size_t base = (size_t)((b * 4 + h) * 2 + dir) * 36 + gc;
#pragma unroll
        for (int nb = 0; nb < 8; ++nb) {
            f32x4 acc = {0.f, 0.f, 0.f, 0.f};
#pragma unroll
            for (int ks = 0; ks < 2; ++ks) { const bf16x8 bv = *(const bf16x8*)(vT + (nb * 16 + row) * 72 + ks * 32 + kg * 8); acc = MFMA16(a[ks], bv, acc); }
            const f32x4 o = {acc[0] * eb[0], acc[1] * eb[1], acc[2] * eb[2], acc[3] * eb[3]};
            *(f32x4*)(DSb + base * 8192 + (size_t)(nb * 16 + row) * 64 + dkb * 16 + kg * 4) = o;
        }
        if (row == 0) *(f32x4*)(DEC + base * 64 + dkb * 16 + kg * 4) = (f32x4){eb[0], eb[1], eb[2], eb[3]};
        __syncthreads();
    }
}
__device__ __forceinline__ void phase_gla_scan(const Params& p, int bid, int G, int tid) {
    const float* DSb = (const float*)(p.ws + WS_DS); const float* DEC = (const float*)(p.ws + WS_DEC); bf16_t* SB = (bf16_t*)(p.ws + WS_SB);
    for (int gt = bid * 512 + tid; gt < 64 * 2048; gt += G * 512) {
        const int bhd = gt >> 11, eg = gt & 2047, dir = bhd & 1, dk4 = (eg & 15) * 4;
        f32x4 S = {0.f, 0.f, 0.f, 0.f};
#pragma unroll 4
        for (int step = 0; step < 36; ++step) {
            const int gc = dir == 0 ? step : (step < 4 ? 3 - step : 39 - step);
            const size_t cb = (size_t)bhd * 36 + gc;
            const f32x4 ds = *(const f32x4*)(DSb + cb * 8192 + (size_t)eg * 4);
            const f32x4 dc = *(const f32x4*)(DEC + cb * 64 + dk4);
            u32x2 w; w.x = pk2(S[0], S[1]); w.y = pk2(S[2], S[3]);
            *(u32x2*)(SB + cb * 8192 + (size_t)eg * 4) = w;
            S = dc * S + ds;
        }
    }
}
__device__ __forceinline__ void phase_gla_out(const Params& p, int e, unsigned char* smem, int bid, int G, int tid, int wid, int lane) {
    const bf16_t* PROJ = (const bf16_t*)(p.ws + WS_PROJ); const float* GLO = (const float*)(p.ws + WS_GLO);
    const bf16_t* SB = (const bf16_t*)(p.ws + WS_SB); bf16_t* MIX = (bf16_t*)(p.ws + WS_MIX);
    const float* gup = p.in[23] + (size_t)e * 2 * 16 * 256; const float* gbb = p.in[24] + (size_t)e * 2 * 256; const float* ng = p.in[25] + (size_t)e * 128;
    const bf16_t* qi = (const bf16_t*)(smem + GL_QI); const bf16_t* ki = (const bf16_t*)(smem + GL_KI); const bf16_t* vT = (const bf16_t*)(smem + GL_VT);
    bf16_t* att = (bf16_t*)(smem + GL_ATT); float* ssq = (float*)(smem + GL_SSQ);
    const int row = lane & 15, kg = lane >> 4;
    for (int u = bid; u < 1152; u += G) {
        int b, gc, h, rowbase; gla_decode(u, b, gc, h, rowbase);
        gla_stage<false>(smem, PROJ, GLO, gup, gbb, rowbase, h, tid);
        {   const int dir = wid >> 2, rb = wid & 3;
            bf16x8 aq[2];
#pragma unroll
            for (int ks = 0; ks < 2; ++ks) aq[ks] = *(const bf16x8*)(qi + (dir * 64 + rb * 16 + row) * 72 + ks * 32 + kg * 8);
#pragma unroll
            for (int cb = 0; cb < 4; ++cb) {
                f32x4 acc = {0.f, 0.f, 0.f, 0.f};
                const bool live = dir == 0 ? (cb <= rb) : (cb >= rb);
                if (live) {
#pragma unroll
                    for (int ks = 0; ks < 2; ++ks) { const bf16x8 bk = *(const bf16x8*)(ki + (dir * 64 + cb * 16 + row) * 72 + ks * 32 + kg * 8); acc = MFMA16(aq[ks], bk, acc); }
                }
#pragma unroll
                for (int i = 0; i < 4; ++i) { const int tq = rb * 16 + kg * 4 + i, tk = cb * 16 + row; const bool keep = dir == 0 ? (tk <= tq) : (tk >= tq);
                    att[(dir * 64 + tq) * 72 + tk] = (bf16_t)f2bf(keep ? acc[i] : 0.f); }
            }
        }
        __syncthreads();
        {   const int dvb = wid;
            bf16x8 bv[2], bs[2][2];
#pragma unroll
            for (int ks = 0; ks < 2; ++ks) bv[ks] = *(const bf16x8*)(vT + (dvb * 16 + row) * 72 + ks * 32 + kg * 8);
#pragma unroll
            for (int dir = 0; dir < 2; ++dir)
#pragma unroll
                for (int ks = 0; ks < 2; ++ks) bs[dir][ks] = *(const bf16x8*)(SB + ((size_t)((b * 4 + h) * 2 + dir) * 36 + gc) * 8192 + (size_t)(dvb * 16 + row) * 64 + ks * 32 + kg * 8);
            f32x4 o[4];
#pragma unroll
            for (int rb = 0; rb < 4; ++rb) { f32x4 acc = {0.f, 0.f, 0.f, 0.f};
#pragma unroll
                for (int dir = 0; dir < 2; ++dir)
#pragma unroll
                    for (int ks = 0; ks < 2; ++ks) {
                        const bf16x8 a1 = *(const bf16x8*)(att + (dir * 64 + rb * 16 + row) * 72 + ks * 32 + kg * 8); acc = MFMA16(a1, bv[ks], acc);
                        const bf16x8 a2 = *(const bf16x8*)(qi + (dir * 64 + rb * 16 + row) * 72 + ks * 32 + kg * 8); acc = MFMA16(a2, bs[dir][ks], acc); }
                o[rb] = acc; }
#pragma unroll
            for (int rb = 0; rb < 4; ++rb)
#pragma unroll
                for (int i = 0; i < 4; ++i) { float s = o[rb][i] * o[rb][i];
                    s += __shfl_xor(s, 1); s += __shfl_xor(s, 2); s += __shfl_xor(s, 4); s += __shfl_xor(s, 8);
                    if (row == 0) ssq[wid * 64 + rb * 16 + kg * 4 + i] = s; }
            __syncthreads();
            const int dv = dvb * 16 + row; const float gn = ng[dv];
#pragma unroll
            for (int rb = 0; rb < 4; ++rb)
#pragma unroll
                for (int i = 0; i < 4; ++i) { const int tok = rb * 16 + kg * 4 + i; float t = 0.f;
#pragma unroll
                    for (int w = 0; w < 8; ++w) t += ssq[w * 64 + tok];
                    const float rstd = rsqrtf(t * (1.f / 128.f) + RMS_EPS);
                    const float gval = bf2f(PROJ[(size_t)(rowbase + tok) * EINP + 2560 + h * 128 + dv]);
                    MIX[(size_t)(rowbase + tok) * 1024 + 512 + h * 128 + dv] = (bf16_t)f2bf(o[rb][i] * rstd * gn * silu_f(gval)); }
        }
        __syncthreads();
    }
}
#ifndef MK_MULTI
#define MK_MULTI 0
#endif
__global__ void __launch_bounds__(512) mega_fwd(Params p) {
    extern __shared__ __attribute__((aligned(16))) unsigned char smem[];
    cg::grid_group grid = cg::this_grid();
    const int bid = blockIdx.x, G = gridDim.x;
    PG8_LAS unsigned char* lds3 = (PG8_LAS unsigned char*)smem;
    int ph = 0;
#define PH_BEGIN if (ph >= p.lo && ph < p.hi) { const int tid = otid(); const int wid = __builtin_amdgcn_readfirstlane(tid >> 6), lane = tid & 63; unsigned char* ws = p.ws; asm volatile("" : "+s"(ws)); (void)wid; (void)lane; (void)ws;
#define PH_END   if (ph + 1 < p.hi) grid.sync(); } ++ph;

    PH_BEGIN
#ifndef SKIP_MISC
 phase_mod_filters(p, smem, bid, G, tid, wid, lane);
#endif
 PH_END
    PH_BEGIN
#ifndef SKIP_MISC
 phase_convert_init(p, smem, bid, G, tid, wid, lane);
#endif
 PH_END

    for (int sl = 0; sl < 12; ++sl) {
        const int l = sl / 3, kind = sl % 3;
        const bool lastl = (l == 3), even = ((l & 1) == 0);
        const int eo = l >> 1;
        const int Mtail = (lastl && kind >= 1) ? R_LAT : R_ALL;
        if (kind != 1) {
            const int s = kind == 0 ? 0 : 1;
            PH_BEGIN
                pg8::Gemm g{(const pg8::bf16_t*)(ws + WS_A), (const pg8::bf16_t*)(ws + WS_WT1) + (size_t)(l * 2 + s) * 5632 * 1024, Mtail, 5632, 1024};
                pg8::StaticOrder S; S.init(g.M, g.N, G, bid);
                pg8::EpiSwiglu E{(pg8::bf16_t*)(ws + WS_ACT)};

#ifndef SKIP_G1
                pg8::gemm_phase<pg8::EpiSwiglu, pg8::StaticOrder, true, true>(lds3, g, S, E);
#endif

            PH_END
        } else {
            PH_BEGIN
                pg8::Gemm g{(const pg8::bf16_t*)(ws + WS_A), even ? (const pg8::bf16_t*)(ws + WS_WEI) + (size_t)eo * EINP * 1024 : (const pg8::bf16_t*)(ws + WS_WAI) + (size_t)eo * OIN * 1024,
                            R_ALL, even ? EINP : OIN, 1024};
                pg8::StaticOrder S; S.init(g.M, g.N, G, bid);
                pg8::EpiProj E{(pg8::bf16_t*)(ws + WS_PROJ), even ? EINP : OIN, even ? 3072 : (1 << 30), (float*)(ws + WS_GLO)};

#ifndef SKIP_PROJ
                pg8::gemm_phase<pg8::EpiProj, pg8::StaticOrder, true, true>(lds3, g, S, E);
#endif

            PH_END
            if (even) {
                PH_BEGIN
#ifndef SKIP_EVEN
 phase_shortconv(p, eo, smem, bid, G, tid); phase_gla_ds(p, eo, smem, bid, G, tid, wid, lane);
#endif
 PH_END
                PH_BEGIN
#ifndef SKIP_EVEN
                    phase_gla_scan(p, bid, G, tid);
                    for (int u = bid; u < 1024; u += G) {
                        const int set = u >= 512, c = u & 511, L = set ? 256 : 2048;
                        const float* kf = (set ? (const float*)(ws + WS_KFC) : (const float*)(ws + WS_KFL)) + (size_t)eo * 2 * 512 * L;
                        bf16_t* zt = (set ? (bf16_t*)(ws + WS_ZTC) : (bf16_t*)(ws + WS_ZTL)) + (size_t)c * 8 * L;
                        toeplitz_unit(smem, kf + (size_t)c * L, kf + (size_t)(512 + c) * L, zt, p.in[22][eo * 512 + c], L, tid, wid, lane);
                    }
#endif
                PH_END
                PH_BEGIN
#ifndef SKIP_EVEN
 phase_gla_out(p, eo, smem, bid, G, tid, wid, lane); phase_hyena_fin(p, smem, bid, G, tid);
#endif
 PH_END
            } else {
                PH_BEGIN
#ifndef SKIP_MISC
 phase_normrope(p, eo, bid, G, wid, lane);
#endif
 PH_END
                PH_BEGIN
#ifndef SKIP_ATTN
 phase_attn(p, !lastl, smem, bid, G);
#endif
 PH_END
            }
        }
        PH_BEGIN
            const pg8::bf16_t* Aop; const pg8::bf16_t* Bop; int K; float scale;
            if (kind != 1) { const int s = kind == 0 ? 0 : 1; Aop = (const pg8::bf16_t*)(ws + WS_ACT); Bop = (const pg8::bf16_t*)(ws + WS_WT2) + (size_t)(l * 2 + s) * 1024 * 2816; K = 2816; scale = 0.5f; }
            else { Aop = (const pg8::bf16_t*)(ws + WS_MIX); Bop = (even ? (const pg8::bf16_t*)(ws + WS_WEO) : (const pg8::bf16_t*)(ws + WS_WAO)) + (size_t)eo * 1024 * 1024; K = 1024; scale = 1.f; }
            pg8::Gemm g{Aop, Bop, Mtail, 1024, K};
            pg8::StaticOrder S; S.init(g.M, g.N, G, bid);
            pg8::EpiResid E{(float*)(ws + WS_H), (const float*)(ws + WS_MODV) + (size_t)l * 9 * NMODC + (size_t)(3 * kind + 2) * 1024, scale};

#ifndef SKIP_RESID
            pg8::gemm_phase<pg8::EpiResid, pg8::StaticOrder, true, true>(lds3, g, S, E);
#endif

        PH_END
        PH_BEGIN
#ifndef SKIP_MISC
 phase_ln(p, sl, Mtail, bid, G, wid, lane);
#endif
 PH_END
    }
#undef PH_BEGIN
#undef PH_END
}

extern "C" void kernel_launch(void* const* d_in, const int* in_sizes, int n_in, void* d_out, int out_size, void* d_ws, size_t ws_size, hipStream_t stream) {
    static int grid = 0;
    if (grid == 0) {
        if (n_in != 30 || out_size != R_LAT * DM || ws_size < WS_END) { fprintf(stderr, "kernel_launch: unexpected shapes: n_in %d out %d ws %zu (need %zu)\n", n_in, out_size, ws_size, (size_t)WS_END); grid = -1; return; }
        int dev = 0, cus = 0, per_cu = 0;
        hipGetDevice(&dev); hipDeviceGetAttribute(&cus, hipDeviceAttributeMultiprocessorCount, dev);
        if (hipFuncSetAttribute((const void*)mega_fwd, hipFuncAttributeMaxDynamicSharedMemorySize, LDS_BYTES) != hipSuccess) { fprintf(stderr, "kernel_launch: hipFuncSetAttribute failed\n"); grid = -1; return; }
        if (hipOccupancyMaxActiveBlocksPerMultiprocessor(&per_cu, (const void*)mega_fwd, 512, LDS_BYTES) != hipSuccess || per_cu < 1) { fprintf(stderr, "kernel_launch: occupancy query gives %d\n", per_cu); per_cu = 1; }
        (void)hipGetLastError();
        grid = cus * 1;
        if (grid <= 0) grid = 256;
    }
    if (grid < 0) return;
    Params p{};
    for (int i = 0; i < 30; ++i) p.in[i] = (const float*)d_in[i];
    p.out = (float*)d_out; p.ws = (unsigned char*)d_ws;
#if MK_MULTI
    for (int ph = 0; ph < NPHASES; ++ph) { p.lo = ph; p.hi = ph + 1; hipLaunchKernelGGL(mega_fwd, dim3(grid), dim3(512), LDS_BYTES, stream, p); }
#else
    p.lo = 0; p.hi = NPHASES;
    void* args[] = {&p};
    hipError_t e = hipLaunchCooperativeKernel((const void*)mega_fwd, dim3(grid), dim3(512), args, LDS_BYTES, stream);
    if (e != hipSuccess) fprintf(stderr, "kernel_launch: cooperative launch failed: %s (grid %d)\n", hipGetErrorString(e), grid);
#endif
}
```

```cpp
#include <hip/hip_runtime.h>
#include <hip/hip_cooperative_groups.h>
#include <cstdio>
#include <cstdint>
#include <cmath>
namespace cg = cooperative_groups;

constexpr int DM = 1024, NBATCH = 8, SEQ = 2048, CTXL = 256;
constexpr int R_LAT = NBATCH * SEQ, R_CTX = NBATCH * CTXL, R_ALL = R_LAT + R_CTX;
constexpr int FH = 2816, EIN = 3104, EINP = 3328, OIN = 1536, NMODC = 9216;
constexpr float ALPHA = 1.681792830507429f;
constexpr float LN_EPS = 1e-5f, RMS_EPS = 1e-6f;
constexpr int NPHASES = 48;

constexpr size_t al256(size_t x) { return (x + 255) / 256 * 256; }
constexpr size_t WS_CTL = 0;
constexpr size_t WS_WT1 = 16384;
constexpr size_t WS_WT2 = WS_WT1 + 8ull * 5632 * 1024 * 2;
constexpr size_t WS_WEI = WS_WT2 + 8ull * 1024 * 2816 * 2;
constexpr size_t WS_WEO = WS_WEI + 2ull * EINP * 1024 * 2;
constexpr size_t WS_WAI = WS_WEO + 2ull * 1024 * 1024 * 2;
constexpr size_t WS_WAO = WS_WAI + 2ull * OIN * 1024 * 2;
constexpr size_t WS_MODV = WS_WAO + 2ull * 1024 * 1024 * 2;
constexpr size_t WS_KFL = WS_MODV + al256(4ull * 9 * NMODC * 4);
constexpr size_t WS_KFC = WS_KFL + 2ull * 2 * 512 * 2048 * 4;
constexpr size_t WS_H = WS_KFC + 2ull * 2 * 512 * 256 * 4;
constexpr size_t WS_A = WS_H + (size_t)R_ALL * 1024 * 4;
constexpr size_t WS_U = WS_A + (size_t)R_ALL * 1024 * 2;
constexpr size_t WS_ACT = WS_U;
constexpr size_t WS_PROJ = WS_U;
constexpr size_t WS_MIX = WS_PROJ + (size_t)R_ALL * EINP * 2;
constexpr size_t WS_GLO = WS_MIX + (size_t)R_ALL * 1024 * 2;
constexpr size_t WS_X = WS_GLO + (size_t)R_ALL * 32 * 4;
constexpr size_t WS_P2 = WS_X;
constexpr size_t WS_ZTL = WS_P2 + (size_t)R_ALL * 512 * 2;
constexpr size_t WS_ZTC = WS_ZTL + 512ull * 8 * 2048 * 2;
constexpr size_t WS_DS = WS_ZTC + 512ull * 8 * 256 * 2;
constexpr size_t WS_DEC = WS_DS + 64ull * 36 * 8192 * 4;
constexpr size_t WS_SB = WS_DEC + 64ull * 36 * 64 * 4;
constexpr size_t WS_END_E = WS_SB + 64ull * 36 * 8192 * 2;
constexpr size_t WS_QB = WS_X;
constexpr size_t WS_KB = WS_QB + (size_t)R_ALL * 1024 * 2;
constexpr size_t WS_VB = WS_KB + 8ull * 2 * 2304 * 128 * 2;
constexpr size_t WS_END = WS_END_E;
constexpr int LDS_BYTES = 136 * 1024;

typedef float f32x4 __attribute__((ext_vector_type(4)));
typedef unsigned u32x4 __attribute__((ext_vector_type(4)));
typedef unsigned u32x2 __attribute__((ext_vector_type(2)));

__device__ __forceinline__ unsigned f2bf(float f) { unsigned u = __builtin_bit_cast(unsigned, f); return (u + 0x7fffu + ((u >> 16) & 1u)) >> 16; }
__device__ __forceinline__ unsigned pk2(float lo, float hi) { return f2bf(lo) | (f2bf(hi) << 16); }
__device__ __forceinline__ float bf2f(unsigned short h) { return __builtin_bit_cast(float, (unsigned)h << 16); }
__device__ __forceinline__ float bflo(unsigned w) { return __builtin_bit_cast(float, w << 16); }
__device__ __forceinline__ float bfhi(unsigned w) { return __builtin_bit_cast(float, w & 0xffff0000u); }
__device__ __forceinline__ float silu_f(float x) { return x * __builtin_amdgcn_rcpf(1.f + __expf(-x)); }
__device__ __forceinline__ float wave_sum(float v) {
#pragma unroll
    for (int o = 1; o < 64; o <<= 1) v += __shfl_xor(v, o);
    return v;
}
#define LDS_WAIT() asm volatile("s_waitcnt lgkmcnt(0)" ::: "memory")
__device__ __forceinline__ int otid() { int t = threadIdx.x; asm volatile("" : "+v"(t)); return t; }
namespace pg8 {
#define PG8_LAS __attribute__((address_space(3)))
typedef unsigned short bf16_t;
typedef short bf16x8 __attribute__((ext_vector_type(8)));
typedef float f32x4 __attribute__((ext_vector_type(4)));
typedef unsigned u32x4 __attribute__((ext_vector_type(4)));
constexpr int BM = 256, BK = 64, HALF = 128, HTB = HALF * BK * 2  , STAGE_BYTES = 8 * HTB, NXCD = 8, WGM = 8;

__host__ __device__ __forceinline__ int lds_byte(int r, int c) { const int st = (r >> 4) * 2 + (c >> 5), rr = r & 15, cc = c & 31, ob = rr * 64 + cc * 2; return st * 1024 + (ob ^ (((ob >> 9) & 1) << 5)); }
__host__ __device__ __forceinline__ void stage_rc(int b, int& R, int& C) { const int st = b / 1024, sb = b % 1024, swz = sb ^ (((sb >> 9) & 1) << 5); R = (st >> 1) * 16 + swz / 64; C = (st & 1) * 32 + (swz % 64) / 2; }
__host__ __device__ __forceinline__ int perm32(int rho) { const int n = rho >> 4, i = rho & 15; return 8 * (i >> 2) + 4 * n + (i & 3); }

struct Unit { int pm, pn; };
struct Gemm { const bf16_t* A; const bf16_t* Bt; int M, N, K; };

struct StaticOrder {
    int nM, nN, nwg, G, c;
    __host__ __device__ void init(int M, int N, int G_, int c_) { nM = M / BM; nN = N / BM; nwg = nM * nN; G = G_; c = c_; }
    __host__ __device__ bool next(int i, Unit& u) const {
        const long L = (long)i * G + c; if (L >= nwg) return false;
        int wgid = (int)L; { const int q = nwg / NXCD, r = nwg % NXCD, xcd = wgid % NXCD, off = wgid / NXCD; wgid = (xcd < r ? xcd * (q + 1) : r * (q + 1) + (xcd - r) * q) + off; }
        const int nig = WGM * nN, gid = wgid / nig, fm = gid * WGM, gsz = (nM - fm) < WGM ? (nM - fm) : WGM;
        u.pm = fm + ((wgid % nig) % gsz); u.pn = (wgid % nig) / gsz; return true;
    }
    __device__ __forceinline__ void a_ready(const Unit&) const {}
    __device__ __forceinline__ void done(const Unit&) const {}
};

struct EpiSwiglu {
    static constexpr bool PERM = true, AFTER_DRAIN = false;
    bf16_t* O;
    __device__ __forceinline__ void operator()(const f32x4 (&acc)[2][2][4][2], const Unit& u, int wr, int wc, int fr, int fq) const {
        const int row0 = u.pm * BM + wr * 64 + fr, col0 = u.pn * 128 + wc * 32 + 8 * fq;
#pragma unroll
        for (int ai = 0; ai < 2; ++ai)
#pragma unroll
            for (int m = 0; m < 4; ++m) {
                bf16_t* rowp = O + (size_t)(row0 + ai * HALF + m * 16) * FH + col0;
                const f32x4 g0 = acc[ai][0][m][0], g1 = acc[ai][0][m][1], u0 = acc[ai][1][m][0], u1 = acc[ai][1][m][1];
                u32x4 w;
                w.x = pk2(silu_f(g0[0]) * u0[0], silu_f(g0[1]) * u0[1]); w.y = pk2(silu_f(g0[2]) * u0[2], silu_f(g0[3]) * u0[3]);
                w.z = pk2(silu_f(g1[0]) * u1[0], silu_f(g1[1]) * u1[1]); w.w = pk2(silu_f(g1[2]) * u1[2], silu_f(g1[3]) * u1[3]);
                *(u32x4*)rowp = w;
            }
    }
};
struct EpiResid {
    static constexpr bool PERM = false, AFTER_DRAIN = false;
    float* H; const float* gate; float scale;
    __device__ __forceinline__ void operator()(const f32x4 (&acc)[2][2][4][2], const Unit& u, int wr, int wc, int fr, int fq) const {
        const int b = u.pm < 64 ? (u.pm >> 3) : 8;
        const float* gt = gate + (size_t)b * NMODC;
        const int row0 = u.pm * BM + wr * 64 + fr, col0 = u.pn * BM + wc * 32 + 4 * fq;
#pragma unroll
        for (int bj = 0; bj < 2; ++bj)
#pragma unroll
            for (int n = 0; n < 2; ++n) {
                const f32x4 gv = *(const f32x4*)(gt + col0 + bj * HALF + n * 16) * scale;
#pragma unroll
                for (int ai = 0; ai < 2; ++ai)
#pragma unroll
                    for (int m = 0; m < 4; ++m) {
                        float* ptr = H + (size_t)(row0 + ai * HALF + m * 16) * DM + col0 + bj * HALF + n * 16;
                        const f32x4 h = *(const f32x4*)ptr;
                        *(f32x4*)ptr = h * ALPHA + gv * acc[ai][bj][m][n];
                    }
            }
    }
};
struct EpiProj {
    static constexpr bool PERM = true, AFTER_DRAIN = false;
    bf16_t* O; int ldc; int f32_start; float* GL;
    __device__ __forceinline__ void operator()(const f32x4 (&acc)[2][2][4][2], const Unit& u, int wr, int wc, int fr, int fq) const {
        const int row0 = u.pm * BM + wr * 64 + fr, colt = u.pn * BM;
        if (colt >= f32_start) {
            if (wc == 0) {
#pragma unroll
                for (int ai = 0; ai < 2; ++ai)
#pragma unroll
                    for (int m = 0; m < 4; ++m) {
                        float* gp = GL + (size_t)(row0 + ai * HALF + m * 16) * 32 + 8 * fq;
                        *(f32x4*)gp = acc[ai][0][m][0]; *(f32x4*)(gp + 4) = acc[ai][0][m][1];
                    }
            }
        } else {
            const int col0 = colt + wc * 32 + 8 * fq;
#pragma unroll
            for (int ai = 0; ai < 2; ++ai)
#pragma unroll
                for (int m = 0; m < 4; ++m) {
                    bf16_t* rowp = O + (size_t)(row0 + ai * HALF + m * 16) * ldc + col0;
#pragma unroll
                    for (int bj = 0; bj < 2; ++bj) {
                        const f32x4 v0 = acc[ai][bj][m][0], v1 = acc[ai][bj][m][1];
                        u32x4 w; w.x = pk2(v0[0], v0[1]); w.y = pk2(v0[2], v0[3]); w.z = pk2(v1[0], v1[1]); w.w = pk2(v1[2], v1[3]);
                        *(u32x4*)(rowp + bj * HALF) = w;
                    }
                }
        }
    }
};
template <class Epi, class Sched, bool ALIGN_EPI = false, bool SP2 = false>
__device__ __forceinline__ void gemm_phase(PG8_LAS unsigned char* lds, const Gemm g, const Sched& S, const Epi& E) {
    const int tid = otid(), wid = __builtin_amdgcn_readfirstlane(tid >> 6), lane = tid & 63, wr = wid >> 2, wc = wid & 3, fr = lane & 15, fq = lane >> 4;
    const int K = g.K, nt = K / BK;
    unsigned voffA[2], voffB[2];
#pragma unroll
    for (int i = 0; i < 2; ++i) { int R, C; stage_rc(tid * 16 + i * 8192, R, C); const int Rb = Epi::PERM ? ((R & ~31) + perm32(R & 31)) : R;
        voffA[i] = (unsigned)(R * K + C) * 2u; voffB[i] = (unsigned)(Rb * K + C) * 2u; }
    const size_t kstep = (size_t)(BK * 2);
    const size_t hstep = (size_t)HALF * K * 2;
    const size_t tstep = 2 * hstep;
    const unsigned ldsw = (unsigned)wid * 1024u;
    const int aoff = lds_byte(wr * 64 + fr, fq * 8), boff = lds_byte(wc * 32 + fr, fq * 8);
#define PG8_SA(b, h) (((b) * 2 + (h)) * HTB)
#define PG8_SB(b, h) ((4 + (b) * 2 + (h)) * HTB)
#define PG8_STAGE(bufoff, gbase, voff) do { _Pragma("unroll") for (int _i = 0; _i < 2; ++_i) \
        __builtin_amdgcn_global_load_lds((const unsigned*)((const char*)(gbase) + (voff)[_i]), (PG8_LAS unsigned*)(lds + (bufoff) + ldsw + _i * 8192), 16, 0, 0); } while (0)
#define PG8_LDA(dst, b, h) do { _Pragma("unroll") for (int m = 0; m < 4; ++m) _Pragma("unroll") for (int k = 0; k < 2; ++k) dst[m][k] = *(const PG8_LAS bf16x8*)(lds + PG8_SA(b, h) + aoff + m * 2048 + k * 1024); } while (0)
#define PG8_LDB(dst, b, h) do { _Pragma("unroll") for (int n = 0; n < 2; ++n) _Pragma("unroll") for (int k = 0; k < 2; ++k) dst[n][k] = *(const PG8_LAS bf16x8*)(lds + PG8_SB(b, h) + boff + n * 2048 + k * 1024); } while (0)
#define PG8_MMA(ai, bj, At, Bt) do { __builtin_amdgcn_s_setprio(1); _Pragma("unroll") for (int m = 0; m < 4; ++m) _Pragma("unroll") for (int n = 0; n < 2; ++n) _Pragma("unroll") for (int k = 0; k < 2; ++k) \
        acc[ai][bj][m][n] = __builtin_amdgcn_mfma_f32_16x16x32_bf16(Bt[n][k], At[m][k], acc[ai][bj][m][n], 0, 0, 0); __builtin_amdgcn_s_setprio(0); } while (0)
#define PG8_WAIT_V(n) asm volatile("s_waitcnt vmcnt(" #n ")" ::: "memory")
#define PG8_WAIT_L(n) asm volatile("s_waitcnt lgkmcnt(" #n ")" ::: "memory")
#define PG8_BAR __builtin_amdgcn_s_barrier()
#define PG8_SCHED __builtin_amdgcn_sched_barrier(0)
    Unit cur, nxt; int ui = 0;
    if (!S.next(0, cur)) return;
    f32x4 acc[2][2][4][2];
#pragma unroll
    for (int a = 0; a < 2; ++a)
#pragma unroll
        for (int b = 0; b < 2; ++b)
#pragma unroll
            for (int m = 0; m < 4; ++m)
#pragma unroll
                for (int n = 0; n < 2; ++n) acc[a][b][m][n] = (f32x4){0.f, 0.f, 0.f, 0.f};
    bf16x8 At[4][2], B0[2][2], B1[2][2];
    const char* cA = (const char*)g.A + (size_t)cur.pm * tstep; const char* cB = (const char*)g.Bt + (size_t)cur.pn * tstep;
    S.a_ready(cur);
    if constexpr (SP2) {
        PG8_STAGE(PG8_SB(0, 0), cB, voffB); PG8_STAGE(PG8_SB(0, 1), cB + hstep, voffB); PG8_STAGE(PG8_SA(0, 0), cA, voffA); PG8_STAGE(PG8_SA(0, 1), cA + hstep, voffA);
        if (wr == 1) PG8_BAR;
        PG8_WAIT_V(2); PG8_BAR;
        PG8_STAGE(PG8_SB(1, 0), cB + kstep, voffB); PG8_STAGE(PG8_SA(1, 0), cA + kstep, voffA); PG8_STAGE(PG8_SB(1, 1), cB + hstep + kstep, voffB);
        PG8_WAIT_V(6); PG8_BAR;
    } else {
        PG8_STAGE(PG8_SB(0, 0), cB, voffB); PG8_STAGE(PG8_SA(0, 0), cA, voffA); PG8_STAGE(PG8_SB(0, 1), cB + hstep, voffB); PG8_STAGE(PG8_SA(0, 1), cA + hstep, voffA);
        if (wr == 1) PG8_BAR;
        PG8_WAIT_V(4); PG8_BAR;
        PG8_STAGE(PG8_SB(1, 0), cB + kstep, voffB); PG8_STAGE(PG8_SA(1, 0), cA + kstep, voffA); PG8_STAGE(PG8_SB(1, 1), cB + hstep + kstep, voffB);
        PG8_WAIT_V(6); PG8_BAR;
    }
    for (;;) {
        const bool has_next = S.next(ui + 1, nxt);
        const char* nA = has_next ? (const char*)g.A + (size_t)nxt.pm * tstep : cA; const char* nB = has_next ? (const char*)g.Bt + (size_t)nxt.pn * tstep : cB;
        for (int t = 0; t < nt; t += 2) {
            const bool last = (t == nt - 2);
            const char* a1 = cA + (size_t)(t + 1) * kstep;
            const char* a2 = last ? nA : cA + (size_t)(t + 2) * kstep; const char* b2 = last ? nB : cB + (size_t)(t + 2) * kstep;
            const char* a3 = a2 + kstep; const char* b3 = b2 + kstep;
            if (last && has_next) S.a_ready(nxt);
            if constexpr (SP2) {
            PG8_LDB(B0, 0, 0); PG8_LDB(B1, 0, 1); PG8_SCHED; PG8_LDA(At, 0, 0); PG8_STAGE(PG8_SA(1, 1), a1 + hstep, voffA);
            PG8_WAIT_V(8); PG8_WAIT_L(0); PG8_BAR; PG8_MMA(0, 0, At, B0); PG8_MMA(0, 1, At, B1); PG8_BAR; PG8_SCHED;
            PG8_LDA(At, 0, 1); PG8_STAGE(PG8_SB(0, 0), b2, voffB); PG8_STAGE(PG8_SB(0, 1), b2 + hstep, voffB); PG8_STAGE(PG8_SA(0, 0), a2, voffA);
            PG8_WAIT_V(8); PG8_WAIT_L(0); PG8_BAR; PG8_MMA(1, 0, At, B0); PG8_MMA(1, 1, At, B1); PG8_BAR; PG8_SCHED;
            PG8_LDB(B0, 1, 0); PG8_LDB(B1, 1, 1); PG8_SCHED; PG8_LDA(At, 1, 0); PG8_STAGE(PG8_SA(0, 1), a2 + hstep, voffA);
            PG8_WAIT_V(8); PG8_WAIT_L(0); PG8_BAR; PG8_MMA(0, 0, At, B0); PG8_MMA(0, 1, At, B1); PG8_BAR; PG8_SCHED;
            PG8_LDA(At, 1, 1); PG8_STAGE(PG8_SB(1, 0), b3, voffB); PG8_STAGE(PG8_SB(1, 1), b3 + hstep, voffB); PG8_STAGE(PG8_SA(1, 0), a3, voffA);
            PG8_WAIT_V(8); PG8_WAIT_L(0); PG8_BAR; PG8_MMA(1, 0, At, B0); PG8_MMA(1, 1, At, B1); PG8_BAR; PG8_SCHED;
            } else {
            PG8_LDB(B0, 0, 0); PG8_SCHED; PG8_LDA(At, 0, 0); PG8_STAGE(PG8_SA(1, 1), a1 + hstep, voffA);
            PG8_WAIT_L(8); PG8_BAR; PG8_WAIT_L(0); PG8_MMA(0, 0, At, B0); PG8_BAR; PG8_SCHED;
            PG8_LDB(B1, 0, 1); PG8_STAGE(PG8_SB(0, 0), b2, voffB);
            PG8_BAR; PG8_WAIT_L(0); PG8_MMA(0, 1, At, B1); PG8_BAR;
            PG8_LDA(At, 0, 1); PG8_STAGE(PG8_SA(0, 0), a2, voffA);
            PG8_BAR; PG8_WAIT_L(0); PG8_MMA(1, 0, At, B0); PG8_BAR; PG8_SCHED;
            PG8_STAGE(PG8_SB(0, 1), b2 + hstep, voffB);
            PG8_WAIT_V(6); PG8_BAR; PG8_MMA(1, 1, At, B1); PG8_BAR;
            PG8_LDB(B0, 1, 0); PG8_SCHED; PG8_LDA(At, 1, 0); PG8_STAGE(PG8_SA(0, 1), a2 + hstep, voffA);
            PG8_WAIT_L(8); PG8_BAR; PG8_WAIT_L(0); PG8_MMA(0, 0, At, B0); PG8_BAR; PG8_SCHED;
            PG8_LDB(B1, 1, 1); PG8_STAGE(PG8_SB(1, 0), b3, voffB);
            PG8_BAR; PG8_WAIT_L(0); PG8_MMA(0, 1, At, B1); PG8_BAR;
            PG8_LDA(At, 1, 1); PG8_STAGE(PG8_SA(1, 0), a3, voffA);
            PG8_BAR; PG8_WAIT_L(0); PG8_MMA(1, 0, At, B0); PG8_BAR; PG8_SCHED;
            PG8_STAGE(PG8_SB(1, 1), b3 + hstep, voffB);
            PG8_WAIT_V(6); PG8_BAR; PG8_MMA(1, 1, At, B1); PG8_BAR;
            }
        }
        if constexpr (ALIGN_EPI) { if (wr == 0) PG8_BAR; }
        if constexpr (!Epi::AFTER_DRAIN) { E(acc, cur, wr, wc, fr, fq); S.done(cur); }
        if (!has_next) break;
#pragma unroll
        for (int a = 0; a < 2; ++a)
#pragma unroll
            for (int b = 0; b < 2; ++b)
#pragma unroll
                for (int m = 0; m < 4; ++m)
#pragma unroll
                    for (int n = 0; n < 2; ++n) acc[a][b][m][n] = (f32x4){0.f, 0.f, 0.f, 0.f};
        cur = nxt; cA = nA; cB = nB; ++ui;
        if constexpr (ALIGN_EPI) { if (wr == 1) PG8_BAR; }
    }
    PG8_WAIT_V(0);
    if constexpr (!ALIGN_EPI) { if (wr == 0) PG8_BAR; }
    PG8_BAR;
    if constexpr (Epi::AFTER_DRAIN) { E.fused(acc, cur, wr, wc, fr, fq, lds, wid, lane); S.done(cur); }
#undef PG8_SA
#undef PG8_SB
#undef PG8_STAGE
#undef PG8_LDA
#undef PG8_LDB
#undef PG8_MMA
#undef PG8_WAIT_V
#undef PG8_WAIT_L
#undef PG8_BAR
#undef PG8_SCHED
}
}
namespace attn {
using bf16 = unsigned short;
constexpr int   D = 128, NW = 8, QBLK = 32, KVBLK = 64;
constexpr float SCALE = 0.088388347648318440f;
constexpr float THR = 8.f;
constexpr int SDEPTH = 2;
constexpr int LDQ = 1024, LDK = 128, LDO = 1024;
constexpr size_t SHM_V = KVBLK * D * 2, SHM_K = KVBLK * D * 2, SHM_ATTN = 2 * SHM_V + 2 * SHM_K + NW * 64 * 4;
using bf16x8 = __attribute__((ext_vector_type(8))) short;
using s16x4  = __attribute__((ext_vector_type(4))) short;
using f32x16 = __attribute__((ext_vector_type(16))) float;
using f32x8  = __attribute__((ext_vector_type(8))) float;
using u32x4  = __attribute__((ext_vector_type(4))) unsigned;
#define KSWZ(row, colB) ((row) * 256 + ((colB) ^ (((row) & 7) << 4)))
#define SBAR() __builtin_amdgcn_sched_barrier(0)
__device__ __forceinline__ int crow(int r, int hi) { return (r & 3) + 8 * (r >> 2) + 4 * hi; }
__device__ __forceinline__ unsigned cvtpk(float lo, float hi) {
  unsigned r; asm volatile("v_cvt_pk_bf16_f32 %0, %1, %2" : "=v"(r) : "v"(lo), "v"(hi)); return r;
}
template <typename TIn> struct Stage;
template <> struct Stage<bf16>  { using T = bf16x8;
  __device__ static __forceinline__ T ld8(const bf16* p) { return *reinterpret_cast<const bf16x8*>(p); }
  __device__ static __forceinline__ bf16x8 tobf(T x) { return x; } };
template <> struct Stage<float> { using T = f32x8;
  __device__ static __forceinline__ T ld8(const float* p) { return *reinterpret_cast<const f32x8*>(p); }
  __device__ static __forceinline__ bf16x8 tobf(T x) {
    u32x4 w = {cvtpk(x[0], x[1]), cvtpk(x[2], x[3]), cvtpk(x[4], x[5]), cvtpk(x[6], x[7])}; return *reinterpret_cast<bf16x8*>(&w); } };

__device__ __forceinline__ void partialSM(f32x16& p0, f32x16& p1, float& m_reg, float& mn, float& alpha) {
  constexpr float C = SCALE * 1.4426950408889634f;
  float pmax = p0[0]; for (int r = 1; r < 16; ++r) pmax = fmaxf(pmax, p0[r]); for (int r = 0; r < 16; ++r) pmax = fmaxf(pmax, p1[r]);
  { auto rr = __builtin_amdgcn_permlane32_swap(__float_as_uint(pmax), __float_as_uint(pmax), false, false);
    pmax = fmaxf(__uint_as_float(rr[0]), __uint_as_float(rr[1])); }
  if (__builtin_expect(__all(pmax - m_reg <= THR / SCALE), 1)) { mn = m_reg; alpha = 1.f; }
  else { mn = fmaxf(m_reg, pmax); alpha = __builtin_amdgcn_exp2f((m_reg - mn) * C); m_reg = mn; }
  float mnC = -mn * C;
  for (int r = 0; r < 16; ++r) p0[r] = fmaf(p0[r], C, mnC); for (int r = 0; r < 16; ++r) p1[r] = fmaf(p1[r], C, mnC);
  for (int r = 0; r < 16; ++r) p0[r] = __builtin_amdgcn_exp2f(p0[r]);
}
__device__ __forceinline__ void finishSM(f32x16& p0, f32x16& p1, float alpha, float& l_reg, bf16x8& pa0, bf16x8& pa1, bf16x8& pa2, bf16x8& pa3) {
  for (int r = 0; r < 16; ++r) p1[r] = __builtin_amdgcn_exp2f(p1[r]);
  float ps = 0; for (int r = 0; r < 16; ++r) ps += p0[r]; for (int r = 0; r < 16; ++r) ps += p1[r];
  { auto rr = __builtin_amdgcn_permlane32_swap(__float_as_uint(ps), __float_as_uint(ps), false, false);
    ps = __uint_as_float(rr[0]) + __uint_as_float(rr[1]); }
  l_reg = l_reg * alpha + ps;
#define PK4(P, BASE, OUT) do { unsigned a0 = cvtpk(P[BASE + 0], P[BASE + 1]), a1 = cvtpk(P[BASE + 2], P[BASE + 3]);   \
    unsigned b0 = cvtpk(P[BASE + 4], P[BASE + 5]), b1 = cvtpk(P[BASE + 6], P[BASE + 7]);                              \
    auto r0 = __builtin_amdgcn_permlane32_swap(a0, b0, false, false); auto r1 = __builtin_amdgcn_permlane32_swap(a1, b1, false, false); \
    u32x4 w = {r0[0], r1[0], r0[1], r1[1]}; OUT = *reinterpret_cast<bf16x8*>(&w); } while (0)
  PK4(p0, 0, pa0); PK4(p0, 8, pa1); PK4(p1, 0, pa2); PK4(p1, 8, pa3);
#undef PK4
}
__device__ __forceinline__ void qkt(f32x16& p0, f32x16& p1, const bf16* Ks, const bf16x8* qr, int r32, int hi) {
  p0 = f32x16{}; p1 = f32x16{};
  for (int d0 = 0; d0 < 8; ++d0) { int cb = (d0 * 16 + hi * 8) * 2;
    bf16x8 b0 = *reinterpret_cast<const bf16x8*>((const char*)Ks + KSWZ(r32, cb));
    bf16x8 b1 = *reinterpret_cast<const bf16x8*>((const char*)Ks + KSWZ(32 + r32, cb));
    p0 = __builtin_amdgcn_mfma_f32_32x32x16_bf16(b0, qr[d0], p0, 0, 0, 0);
    p1 = __builtin_amdgcn_mfma_f32_32x32x16_bf16(b1, qr[d0], p1, 0, 0, 0); }
}
__device__ __forceinline__ int v_st(int k, int c) { const int kk = (k & ~0xC) | ((k & 4) << 1) | ((k & 8) >> 1); return ((kk >> 3) * 4 + (c >> 5)) * 512 + ((kk & 7) * 32 + (c & 31)) * 2; }
__device__ __forceinline__ int v_rd_base(int lane) { return ((lane & 3) << 3) | (((lane >> 2) & 3) << 6) | (((lane >> 4) & 1) << 5) | (((lane >> 5) & 1) << 8); }
constexpr int v_rd_off(int d0, int ks, int half) { return d0 * 512 + ks * 4096 + half * 2048; }
template <int OFF> __device__ __forceinline__ s16x4 tr_read(int vb) {
  s16x4 r; asm volatile("ds_read_b64_tr_b16 %0, %1 offset:%2" : "=&v"(r) : "v"(vb), "i"(OFF) : "memory"); return r;
}
template <int D0> __device__ __forceinline__ void pv_one(f32x16& od, int vb, bf16x8 pa0, bf16x8 pa1, bf16x8 pa2, bf16x8 pa3) {
  const s16x4 l0 = tr_read<v_rd_off(D0, 0, 0)>(vb), h0 = tr_read<v_rd_off(D0, 0, 1)>(vb), l1 = tr_read<v_rd_off(D0, 1, 0)>(vb), h1 = tr_read<v_rd_off(D0, 1, 1)>(vb);
  const s16x4 l2 = tr_read<v_rd_off(D0, 2, 0)>(vb), h2 = tr_read<v_rd_off(D0, 2, 1)>(vb), l3 = tr_read<v_rd_off(D0, 3, 0)>(vb), h3 = tr_read<v_rd_off(D0, 3, 1)>(vb);
  asm volatile("s_waitcnt lgkmcnt(0)" ::: "memory"); SBAR();
#define PK(L, H) (bf16x8){L[0], L[1], L[2], L[3], H[0], H[1], H[2], H[3]}
  od = __builtin_amdgcn_mfma_f32_32x32x16_bf16(pa0, PK(l0, h0), od, 0, 0, 0);
  od = __builtin_amdgcn_mfma_f32_32x32x16_bf16(pa1, PK(l1, h1), od, 0, 0, 0);
  od = __builtin_amdgcn_mfma_f32_32x32x16_bf16(pa2, PK(l2, h2), od, 0, 0, 0);
  od = __builtin_amdgcn_mfma_f32_32x32x16_bf16(pa3, PK(l3, h3), od, 0, 0, 0);
#undef PK
}
__device__ __forceinline__ void pv_d0(f32x16* o, int vb, bf16x8 pa0, bf16x8 pa1, bf16x8 pa2, bf16x8 pa3) {
  pv_one<0>(o[0], vb, pa0, pa1, pa2, pa3); pv_one<1>(o[1], vb, pa0, pa1, pa2, pa3); pv_one<2>(o[2], vb, pa0, pa1, pa2, pa3); pv_one<3>(o[3], vb, pa0, pa1, pa2, pa3);
}
template <typename TQ>
__device__ __forceinline__ void attn_dense_body(const TQ* __restrict__ Qb, const bf16* __restrict__ Kh, const bf16* __restrict__ Vh,
                                                bf16* __restrict__ Ob, int seq, char* lds) {
  using St = Stage<bf16>; using SQ = Stage<TQ>;
  const int tid = otid(), wid = tid >> 6, lane = tid & 63, r32 = lane & 31, hi = lane >> 5;
  bf16* V_lds = (bf16*)lds; bf16* K_lds = (bf16*)(lds + 2 * SHM_V);
  float* ws = (float*)(lds + 2 * SHM_V + 2 * SHM_K) + wid * 64; float* li_l = ws; float* al_l = ws + 32;
  float m_reg = -1e30f, l_reg = 0; f32x16 o[4] = {}; bf16x8 qr[8];
  const TQ* Qw = Qb + (long)(wid * QBLK + r32) * LDQ + hi * 8;
#pragma unroll
  for (int d0 = 0; d0 < 8; ++d0) qr[d0] = SQ::tobf(SQ::ld8(Qw + d0 * 16));
  const int sr = tid >> 4, sc = (tid & 15) * 8, vst0 = v_st(sr, sc), vst1 = v_st(32 + sr, sc);
  const int vb0 = (int)(uintptr_t)V_lds + v_rd_base(lane);
  struct { typename St::T vs0, vs1, ks0, ks1; } sr_[SDEPTH];
#define SLOAD(i, k0) do { sr_[i].vs0 = St::ld8(&Vh[(long)((k0) + sr) * LDK + sc]); sr_[i].vs1 = St::ld8(&Vh[(long)((k0) + 32 + sr) * LDK + sc]); \
    sr_[i].ks0 = St::ld8(&Kh[(long)((k0) + sr) * LDK + sc]); sr_[i].ks1 = St::ld8(&Kh[(long)((k0) + 32 + sr) * LDK + sc]); } while (0)
#define SWRITE(b, i) do { *(bf16x8*)((char*)V_lds + (b) * SHM_V + vst0) = St::tobf(sr_[i].vs0);          \
    *(bf16x8*)((char*)V_lds + (b) * SHM_V + vst1) = St::tobf(sr_[i].vs1); int kc = sc * 2;               \
    *(bf16x8*)((char*)K_lds + (b) * SHM_K + KSWZ(sr, kc)) = St::tobf(sr_[i].ks0);                       \
    *(bf16x8*)((char*)K_lds + (b) * SHM_K + KSWZ(32 + sr, kc)) = St::tobf(sr_[i].ks1); } while (0)
#define SWAIT() do { if constexpr (SDEPTH == 2) asm volatile("s_waitcnt vmcnt(4)" ::: "memory"); else asm volatile("s_waitcnt vmcnt(0)" ::: "memory"); } while (0)
#define RESC(a) do { if (__any((a) < 1.f)) { if (hi == 0) al_l[r32] = (a); asm volatile("s_waitcnt lgkmcnt(0)" ::: "memory"); \
    for (int d = 0; d < 4; ++d) for (int r = 0; r < 16; ++r) o[d][r] *= al_l[crow(r, hi)]; } } while (0)
  f32x16 pA0, pA1, pB0, pB1; float mnA, mnB, alA, alB; bf16x8 pa0, pa1, pa2, pa3; const int NT = seq / KVBLK;
  constexpr int SE = 0, SO = SDEPTH - 1;
  SLOAD(SE, 0); asm volatile("s_waitcnt vmcnt(0)" ::: "memory"); SWRITE(0, SE); __syncthreads();
  qkt(pA0, pA1, K_lds, qr, r32, hi); partialSM(pA0, pA1, m_reg, mnA, alA);
  SLOAD(SO, KVBLK); if constexpr (SDEPTH == 2) { if (2 < NT) SLOAD(SE, 2 * KVBLK); }
  SWAIT(); SWRITE(1, SO); __syncthreads();
  for (int j = 1; j + 1 < NT; j += 2) {
    SBAR(); qkt(pB0, pB1, (bf16*)((char*)K_lds + SHM_K), qr, r32, hi);
    finishSM(pA0, pA1, alA, l_reg, pa0, pa1, pa2, pa3); SBAR();
    SLOAD(SO, (j + SDEPTH) * KVBLK); SBAR();
    pv_d0(o, vb0, pa0, pa1, pa2, pa3); partialSM(pB0, pB1, m_reg, mnB, alB);
    __syncthreads(); SWAIT(); SWRITE(0, SE);
    RESC(alB); __syncthreads();
    SBAR(); qkt(pA0, pA1, K_lds, qr, r32, hi);
    finishSM(pB0, pB1, alB, l_reg, pa0, pa1, pa2, pa3); SBAR();
    if (SDEPTH == 1 || j + 3 < NT) SLOAD(SE, (j + 1 + SDEPTH) * KVBLK); SBAR();
    pv_d0(o, vb0 + (int)SHM_V, pa0, pa1, pa2, pa3); partialSM(pA0, pA1, m_reg, mnA, alA);
    __syncthreads(); SWAIT(); SWRITE(1, SO);
    RESC(alA); __syncthreads();
  }
  SBAR(); qkt(pB0, pB1, (bf16*)((char*)K_lds + SHM_K), qr, r32, hi);
  finishSM(pA0, pA1, alA, l_reg, pa0, pa1, pa2, pa3); SBAR();
  pv_d0(o, vb0, pa0, pa1, pa2, pa3); partialSM(pB0, pB1, m_reg, mnB, alB);
  __syncthreads(); RESC(alB);
  finishSM(pB0, pB1, alB, l_reg, pa0, pa1, pa2, pa3); SBAR();
  pv_d0(o, vb0 + (int)SHM_V, pa0, pa1, pa2, pa3);
  if (hi == 0) li_l[r32] = l_reg; asm volatile("s_waitcnt lgkmcnt(0)" ::: "memory");
  float rli[16];
#pragma unroll
  for (int r = 0; r < 16; ++r) rli[r] = __builtin_amdgcn_rcpf(li_l[crow(r, hi)]);
  bf16* Ow = Ob + (long)(wid * QBLK) * LDO;
#pragma unroll
  for (int r = 0; r < 16; ++r) { int orow = crow(r, hi);
    for (int d0 = 0; d0 < 4; ++d0) Ow[(long)orow * LDO + d0 * 32 + r32] = (bf16)f2bf(o[d0][r] * rli[r]); }
#undef SLOAD
#undef SWRITE
#undef SWAIT
#undef RESC
}
}
#define LAS __attribute__((address_space(3)))
#define XB_TMO      128
#define XB_XCNT(j)  (256  + 64 * (j))
#define XB_XSUB(j)  (1280 + 64 * (j))
#define XB_XGEN(j)  (2304 + 64 * (j))
#define XB_TOP      3328
#define XB_TOPGEN   3392
#define XCD_BAR_WORDS 3456
#define XB_SPIN_CAP (1u << 18)

__device__ __forceinline__ unsigned xb_ld(unsigned* p)              { return __hip_atomic_load(p, __ATOMIC_RELAXED, __HIP_MEMORY_SCOPE_AGENT); }
__device__ __forceinline__ unsigned xb_add(unsigned* p, unsigned v) { return __hip_atomic_fetch_add(p, v, __ATOMIC_RELAXED, __HIP_MEMORY_SCOPE_AGENT); }
__device__ __forceinline__ unsigned xb_xcc_id() { return (unsigned)__builtin_amdgcn_s_getreg((3 << 11) | 20) & 0xFu; }
#define XB_SPIN(cond, bar) do { unsigned _sp = 0; while (cond) { __builtin_amdgcn_s_sleep(1); \
    if ((++_sp & 255u) == 0u) { if (xb_ld(&(bar)[XB_TMO])) break; if (_sp > XB_SPIN_CAP) { atomicAdd(&(bar)[XB_TMO], 1u); break; } } } } while (0)

struct XcdBarrier {
    unsigned* bar; unsigned x;
    volatile LAS unsigned* st;
};

__device__ __forceinline__ XcdBarrier xcd_barrier_post(unsigned* bar, volatile LAS unsigned* st) {
    XcdBarrier b; b.bar = bar; b.x = xb_xcc_id(); b.st = st;
    if (threadIdx.x == 0) (void)xb_add(&bar[XB_XCNT(b.x)], 1u);
    return b;
}
__device__ __forceinline__ void xcd_barrier_complete(unsigned* bar, unsigned x, unsigned& nloc, unsigned& nx) {
    const unsigned G = gridDim.x * gridDim.y * gridDim.z;
    unsigned sum, cnt, mine, sp = 0u;
    for (;;) {
        sum = 0u; cnt = 0u; mine = 0u;
#pragma unroll
        for (unsigned j = 0; j < 16; ++j) { const unsigned c = xb_ld(&bar[XB_XCNT(j)]); sum += c; cnt += (c > 0u) ? 1u : 0u; mine = (j == x) ? c : mine; }
        if (sum == G) break;
        __builtin_amdgcn_s_sleep(1);
        if ((++sp & 255u) == 0u) { if (xb_ld(&bar[XB_TMO])) break; if (sp > XB_SPIN_CAP) { atomicAdd(&bar[XB_TMO], 1u); break; } }
    }
    nloc = mine > 0u ? mine : 1u; nx = cnt > 0u ? cnt : 1u;
}

__device__ __forceinline__ void xcd_barrier(const XcdBarrier& b) {
    asm volatile("s_waitcnt vmcnt(0)" ::: "memory");
    __syncthreads();
    if (threadIdx.x == 0) {
        unsigned* bar = b.bar;
        __builtin_amdgcn_s_waitcnt(0);
        unsigned nloc = b.st[0], nx = b.st[1];
        if (nloc == 0u) { xcd_barrier_complete(bar, b.x, nloc, nx); b.st[0] = nloc; b.st[1] = nx; }
        const unsigned old = xb_add(&bar[XB_XSUB(b.x)], 1u);
        const unsigned gen = old / nloc;
        if (old + 1u == (gen + 1u) * nloc) {
            __builtin_amdgcn_fence(__ATOMIC_RELEASE, "agent");
            asm volatile("s_waitcnt vmcnt(0)" ::: "memory");
            const unsigned og = xb_add(&bar[XB_TOP], 1u);
            const unsigned tg = og / nx;
            if (og + 1u == (tg + 1u) * nx) xb_add(&bar[XB_TOPGEN], 1u);
            else XB_SPIN(xb_ld(&bar[XB_TOPGEN]) == tg, bar);
            __builtin_amdgcn_fence(__ATOMIC_ACQUIRE, "agent");
            xb_add(&bar[XB_XGEN(b.x)], 1u);
            asm volatile("s_waitcnt vmcnt(0)" ::: "memory");
        } else {
            XB_SPIN(xb_ld(&bar[XB_XGEN(b.x)]) == gen, bar);
            __builtin_amdgcn_fence(__ATOMIC_ACQUIRE, "agent");
            asm volatile("s_waitcnt vmcnt(0)" ::: "memory");
        }
    }
    __syncthreads();
}
typedef unsigned short bf16_t;
typedef short bf16x8 __attribute__((ext_vector_type(8)));
#define MFMA16(a, b, c) __builtin_amdgcn_mfma_f32_16x16x32_bf16((a), (b), (c), 0, 0, 0)

struct Params { const float* in[30]; float* out; unsigned char* ws; int lo, hi; };

__device__ __forceinline__ void phase_mod_filters(const Params& p, unsigned char* smem, int bid, int G, int tid, int wid, int lane) {
    float* sc = (float*)smem;
    float* red = sc + 9 * 1024;
    float* modv = (float*)(p.ws + WS_MODV);
    const float* c = p.in[1]; const float* cctx = p.in[3]; const float* ada_w = p.in[4]; const float* ada_b = p.in[5];
    for (int i = tid; i < 9 * 1024; i += 512) { const int b = i >> 10, k = i & 1023; const float v = b < 8 ? c[b * 1024 + k] : cctx[k]; sc[i] = v / (1.f + __expf(-v)); }
    __syncthreads();
    for (int it = bid; it < 576; it += G) {
        const int l = it / 144, n0 = (it % 144) * 64;
        const float* W = ada_w + (size_t)l * 1024 * NMODC + n0 + lane;
        float acc[9];
#pragma unroll
        for (int b = 0; b < 9; ++b) acc[b] = 0.f;
        const int k0 = wid * 128;
#pragma unroll 8
        for (int k = 0; k < 128; ++k) {
            const float wv = W[(size_t)(k0 + k) * NMODC];
#pragma unroll
            for (int b = 0; b < 9; ++b) acc[b] += sc[b * 1024 + k0 + k] * wv;
        }
#pragma unroll
        for (int b = 0; b < 9; ++b) red[(wid * 9 + b) * 64 + lane] = acc[b];
        __syncthreads();
        for (int i = tid; i < 576; i += 512) {
            const int b = i >> 6, j = i & 63; float s = ada_b[l * NMODC + n0 + j];
#pragma unroll
            for (int w = 0; w < 8; ++w) s += red[(w * 9 + b) * 64 + j];
            modv[(size_t)(l * 9 + b) * NMODC + n0 + j] = s;
        }
        __syncthreads();
    }
    const int gw = bid * 8 + wid, NGW = G * 8;
    const float mind = -3.0701134573253943f, maxd = -15.350567286626972f;
    for (int it = gw; it < 1152; it += NGW) {
        const int e = it / 576, r = it % 576; const int set = r >= 512; const int L = set ? 256 : 2048; const int n0 = (set ? r - 512 : r) * 4;
        const float* w1 = p.in[14] + e * 33 * 64; const float* b1 = p.in[15] + e * 64; const float* fr1 = p.in[16] + e * 64;
        const float* w2 = p.in[17] + e * 64 * 64; const float* b2 = p.in[18] + e * 64; const float* fr2 = p.in[19] + e * 64;
        const float* w3 = p.in[20] + (size_t)e * 64 * 1024; const float* b3 = p.in[21] + e * 1024;
        float* KF = set ? (float*)(p.ws + WS_KFC) + (size_t)e * 2 * 512 * 256 : (float*)(p.ws + WS_KFL) + (size_t)e * 2 * 512 * 2048;
        float h2[4];
#pragma unroll
        for (int q = 0; q < 4; ++q) {
            const int n = n0 + q; const float tt = (float)n / (float)(L - 1);
            float feat = 0.f;
            if (lane == 0) feat = tt;
            else if (lane < 33) { const int bi = (lane - 1) & 15; const float band = 1e-4f + (float)bi * ((15.f - 1e-4f) / 15.f);
                const float ang = ((6.283185307179586f * (float)n) * band) / (float)L; feat = lane < 17 ? cosf(ang) : -sinf(ang); }
            float a1 = b1[lane];
            for (int i = 0; i < 33; ++i) a1 += __shfl(feat, i) * w1[i * 64 + lane];
            const float h1 = sinf(fr1[lane] * a1);
            float a2 = b2[lane];
            for (int j = 0; j < 64; ++j) a2 += __shfl(h1, j) * w2[j * 64 + lane];
            h2[q] = sinf(fr2[lane] * a2);
        }
        for (int m = 0; m < 16; ++m) {
            const int col = m * 64 + lane; float acc[4];
#pragma unroll
            for (int q = 0; q < 4; ++q) acc[q] = b3[col];
            for (int j = 0; j < 64; ++j) { const float wv = w3[j * 1024 + col];
#pragma unroll
                for (int q = 0; q < 4; ++q) acc[q] += __shfl(h2[q], j) * wv; }
            const int dir = col >> 9, w = col & 511;
            const float delta = fabsf(mind + (float)w * ((maxd - mind) / 511.f));
            f32x4 o;
#pragma unroll
            for (int q = 0; q < 4; ++q) { const float tt = (float)(n0 + q) / (float)(L - 1); o[q] = acc[q] * __expf(-tt * delta); }
            *(f32x4*)(KF + (size_t)(dir * 512 + w) * L + n0) = o;
        }
    }
}

__device__ __forceinline__ void transpose_item(const float* W, int K, int N, bf16_t* WT, int mode, float* scr, int item, int lane) {
    const int nblk = N / 32, kb = item / nblk, nb = item % nblk, k0 = 64 * kb, n0 = 32 * nb;
#pragma unroll 8
    for (int i = 0; i < 32; ++i) { const int kk = 2 * i + (lane >> 5); scr[kk * 33 + (lane & 31)] = W[(size_t)(k0 + kk) * N + n0 + (lane & 31)]; }
    LDS_WAIT(); asm volatile("" ::: "memory");
    const int c = lane & 7;
#pragma unroll
    for (int j = 0; j < 4; ++j) { const int n = (lane >> 3) + 8 * j; const float* s = scr + (8 * c) * 33 + n;
        u32x4 o; o.x = pk2(s[0 * 33], s[1 * 33]); o.y = pk2(s[2 * 33], s[3 * 33]); o.z = pk2(s[4 * 33], s[5 * 33]); o.w = pk2(s[6 * 33], s[7 * 33]);
        int dn = n0 + n;
        if (mode == 1) { const int half = dn >= FH ? 1 : 0; const int jj = dn - half * FH; dn = (jj >> 7) * 256 + half * 128 + (jj & 127); }
        *(u32x4*)(WT + (size_t)dn * K + k0 + 8 * c) = o; }
    LDS_WAIT(); asm volatile("" ::: "memory");
}
__device__ __forceinline__ void phase_convert_init(const Params& p, unsigned char* smem, int bid, int G, int tid, int wid, int lane) {
    float* scr = (float*)(smem + wid * 8448);
    const int gw = bid * 8 + wid, NGW = G * 8;
    for (int it = gw; it < 40480; it += NGW) {
        int r = it; const float* W; bf16_t* WT; int K, N, mode = 0;
        if (r < 22528) { const int m = r / 2816; r %= 2816; W = p.in[8] + (size_t)m * 1024 * 5632; WT = (bf16_t*)(p.ws + WS_WT1) + (size_t)m * 5632 * 1024; K = 1024; N = 5632; mode = 1; }
        else if ((r -= 22528) < 11264) { const int m = r / 1408; r %= 1408; W = p.in[9] + (size_t)m * 2816 * 1024; WT = (bf16_t*)(p.ws + WS_WT2) + (size_t)m * 1024 * 2816; K = 2816; N = 1024; }
        else if ((r -= 11264) < 3104) { const int m = r / 1552; r %= 1552; W = p.in[10] + (size_t)m * 1024 * EIN; WT = (bf16_t*)(p.ws + WS_WEI) + (size_t)m * EINP * 1024; K = 1024; N = EIN; }
        else if ((r -= 3104) < 1024) { const int m = r / 512; r %= 512; W = p.in[11] + (size_t)m * 1024 * 1024; WT = (bf16_t*)(p.ws + WS_WEO) + (size_t)m * 1024 * 1024; K = 1024; N = 1024; }
        else if ((r -= 1024) < 1536) { const int m = r / 768; r %= 768; W = p.in[26] + (size_t)m * 1024 * OIN; WT = (bf16_t*)(p.ws + WS_WAI) + (size_t)m * OIN * 1024; K = 1024; N = OIN; }
        else { r -= 1536; const int m = r / 512; r %= 512; W = p.in[27] + (size_t)m * 1024 * 1024; WT = (bf16_t*)(p.ws + WS_WAO) + (size_t)m * 1024 * 1024; K = 1024; N = 1024; }
        transpose_item(W, K, N, WT, mode, scr, r, lane);
    }
    for (int i = bid * 512 + tid; i < 2 * 224 * 128; i += G * 512) { const int m = i / (224 * 128), j = i % (224 * 128);
        *(u32x4*)((bf16_t*)(p.ws + WS_WEI) + (size_t)m * EINP * 1024 + (size_t)EIN * 1024 + (size_t)j * 8) = (u32x4){0u, 0u, 0u, 0u}; }
    const float* modv = (const float*)(p.ws + WS_MODV);
    float* H = (float*)(p.ws + WS_H); bf16_t* A = (bf16_t*)(p.ws + WS_A);
    for (int r = gw; r < R_ALL; r += NGW) {
        const float* src = r < R_LAT ? p.in[0] + (size_t)r * DM : p.in[2] + (size_t)(r - R_LAT) * DM;
        const int b = r < R_LAT ? (r >> 11) : 8;
        const float* sh = modv + (size_t)b * NMODC; const float* scl = sh + 1024;
#pragma unroll
        for (int j = 0; j < 4; ++j) { const int col = 4 * lane + 256 * j;
            const f32x4 v = *(const f32x4*)(src + col); const f32x4 s = *(const f32x4*)(sh + col), q = *(const f32x4*)(scl + col);
            *(f32x4*)(H + (size_t)r * DM + col) = v;
            const f32x4 a = v * (1.f + q) + s;
            u32x2 w; w.x = pk2(a[0], a[1]); w.y = pk2(a[2], a[3]); *(u32x2*)(A + (size_t)r * DM + col) = w; }
    }
}

__device__ __forceinline__ void phase_ln(const Params& p, float* H, bf16_t* A, float* outp, int sl, int nrows, int bid, int G, int wid, int lane) {
    const int gw = bid * 8 + wid, NGW = G * 8;
    const float* g = p.in[6] + (size_t)sl * DM; const float* bt = p.in[7] + (size_t)sl * DM;
    const bool last = sl == 11;
    const int sn = sl + 1, ln_ = sn / 3, slotn = sn % 3;
    const float* modn = (const float*)(p.ws + WS_MODV) + (size_t)(last ? 0 : ln_) * 9 * NMODC + (size_t)(3 * (last ? 0 : slotn)) * 1024;
    for (int r = gw; r < nrows; r += NGW) {
        float* hr = H + (size_t)r * DM; f32x4 v[4]; float s = 0.f;
#pragma unroll
        for (int j = 0; j < 4; ++j) { v[j] = *(const f32x4*)(hr + 4 * lane + 256 * j); s += (v[j][0] + v[j][1]) + (v[j][2] + v[j][3]); }
        const float mean = wave_sum(s) * (1.f / DM); float s2 = 0.f;
#pragma unroll
        for (int j = 0; j < 4; ++j) { v[j] = v[j] - mean; s2 += (v[j][0] * v[j][0] + v[j][1] * v[j][1]) + (v[j][2] * v[j][2] + v[j][3] * v[j][3]); }
        const float rstd = rsqrtf(wave_sum(s2) * (1.f / DM) + LN_EPS);
        const int b = r < R_LAT ? (r >> 11) : 8;
        const float* sh = modn + (size_t)b * NMODC; const float* scl = sh + 1024;
#pragma unroll
        for (int j = 0; j < 4; ++j) { const int col = 4 * lane + 256 * j;
            const f32x4 hv = v[j] * rstd * *(const f32x4*)(g + col) + *(const f32x4*)(bt + col);
            if (last) { *(f32x4*)(outp + (size_t)r * DM + col) = hv; }
            else { *(f32x4*)(hr + col) = hv;
                const f32x4 a = hv * (1.f + *(const f32x4*)(scl + col)) + *(const f32x4*)(sh + col);
                u32x2 w; w.x = pk2(a[0], a[1]); w.y = pk2(a[2], a[3]); *(u32x2*)(A + (size_t)r * DM + col) = w; }
        }
    }
}

__device__ __forceinline__ void phase_normrope(const Params& p, int o, int bid, int G, int wid, int lane) {
    const int gw = bid * 8 + wid, NGW = G * 8;
    const bf16_t* PROJ = (const bf16_t*)(p.ws + WS_PROJ); bf16_t* QB = (bf16_t*)(p.ws + WS_QB); bf16_t* KB = (bf16_t*)(p.ws + WS_KB); bf16_t* VB = (bf16_t*)(p.ws + WS_VB);
    const float* qn = p.in[28] + o * 128; const float* kn = p.in[29] + o * 128;
    const int half = lane >> 5, pp = lane & 31;
    const float invf = powf(10000.f, -(float)pp / 32.f);
    const int i1 = half * 64 + pp, i2 = i1 + 32;
    const float gq1 = qn[i1], gq2 = qn[i2], gk1 = kn[i1], gk2 = kn[i2];
    for (int r = gw; r < R_ALL; r += NGW) {
        const bf16_t* pr = PROJ + (size_t)r * OIN;
        const bool lat = r < R_LAT; const int b = lat ? (r >> 11) : ((r - R_LAT) >> 8); const int t = lat ? (r & 2047) : ((r - R_LAT) & 255);
        float cs = 1.f, sn = 0.f;
        if (lat) { const float pos = (float)(half ? (t & 63) : (t >> 6)); const float ang = pos * invf; cs = cosf(ang); sn = sinf(ang); }
        const int kpos = lat ? t : 2048 + t;
#pragma unroll
        for (int hh = 0; hh < 10; ++hh) {
            const int base = hh < 8 ? hh * 128 : 1024 + (hh - 8) * 128;
            float x1 = bf2f(pr[base + i1]), x2 = bf2f(pr[base + i2]);
            const float ss = wave_sum(x1 * x1 + x2 * x2);
            const float rstd = rsqrtf(ss * (1.f / 128.f) + RMS_EPS);
            x1 *= rstd * (hh < 8 ? gq1 : gk1); x2 *= rstd * (hh < 8 ? gq2 : gk2);
            const float y1 = x1 * cs - x2 * sn, y2 = x2 * cs + x1 * sn;
            bf16_t* dst = hh < 8 ? QB + (size_t)r * 1024 + hh * 128 : KB + ((size_t)(b * 2 + (hh - 8)) * 2304 + kpos) * 128;
            dst[i1] = (bf16_t)f2bf(y1); dst[i2] = (bf16_t)f2bf(y2);
        }
#pragma unroll
        for (int kv = 0; kv < 2; ++kv)
            *(unsigned*)(VB + ((size_t)(b * 2 + kv) * 2304 + kpos) * 128 + 2 * lane) = *(const unsigned*)(pr + 1280 + kv * 128 + 2 * lane);
    }
}

__device__ __forceinline__ void phase_attn(const Params& p, bool need_ctx, unsigned char* smem, int bid, int G) {
    const bf16_t* QB = (const bf16_t*)(p.ws + WS_QB); const bf16_t* KB = (const bf16_t*)(p.ws + WS_KB); const bf16_t* VB = (const bf16_t*)(p.ws + WS_VB);
    bf16_t* MIX = (bf16_t*)(p.ws + WS_MIX);
    const int nunits = 512 + (need_ctx ? 64 : 0);
    for (int u = bid; u < nunits; u += G) {
        size_t qoff, koff; int seq;
        if (u < 512) { const int b = u >> 6, h = (u >> 3) & 7, qb = u & 7; qoff = ((size_t)(b * 2048 + qb * 256)) * 1024 + h * 128; koff = (size_t)(b * 2 + (h >> 2)) * 2304 * 128; seq = 2304; }
        else { const int v = u - 512, b = v >> 3, h = v & 7; qoff = ((size_t)(R_LAT + b * 256)) * 1024 + h * 128; koff = ((size_t)(b * 2 + (h >> 2)) * 2304 + 2048) * 128; seq = 256; }
        attn::attn_dense_body<attn::bf16>(QB + qoff, KB + koff, VB + koff, MIX + qoff, seq, (char*)smem);
        __syncthreads();
    }
}

__device__ __forceinline__ void hy_decode(int u, int& set, int& b, int& t0, int& ct, int& L, int& rowbase) {
    set = u >= 2048; int v = set ? u - 2048 : u; ct = v & 7; v >>= 3;
    if (!set) { t0 = (v & 31) * 64; b = v >> 5; L = 2048; rowbase = b * 2048; } else { t0 = (v & 3) * 64; b = v >> 2; L = 256; rowbase = R_LAT + b * 256; }
}
__device__ __forceinline__ void phase_shortconv(const Params& p, int e, unsigned char* smem, int bid, int G, int tid) {
    const bf16_t* PROJ = (const bf16_t*)(p.ws + WS_PROJ); bf16_t* P2 = (bf16_t*)(p.ws + WS_P2);
    const float* cw = p.in[12] + (size_t)e * 3 * 1536; const float* cb = p.in[13] + (size_t)e * 1536;
    bf16_t* zl = (bf16_t*)smem;
    for (int u = bid; u < 2304; u += G) {
        int set, b, t0, ct, L, rowbase; hy_decode(u, set, b, t0, ct, L, rowbase);
        bf16_t* ZT = set ? (bf16_t*)(p.ws + WS_ZTC) : (bf16_t*)(p.ws + WS_ZTL);
        const bf16_t* pr = PROJ + (size_t)rowbase * EINP;
        const int cl = tid & 63, tr = tid >> 6, c = ct * 64 + cl;
        float w[3][3], bb[3];
#pragma unroll
        for (int pt = 0; pt < 3; ++pt) {
#pragma unroll
            for (int k = 0; k < 3; ++k) w[pt][k] = cw[k * 1536 + pt * 512 + c];
            bb[pt] = cb[pt * 512 + c]; }
        float uu[3][10];
#pragma unroll
        for (int k = 0; k < 10; ++k) { const int t = t0 + tr * 8 + k - 1; const bool ok = t >= 0 && t < L;
#pragma unroll
            for (int pt = 0; pt < 3; ++pt) uu[pt][k] = ok ? bf2f(pr[(size_t)t * EINP + pt * 512 + c]) : 0.f; }
#pragma unroll
        for (int i = 0; i < 8; ++i) { float pv[3];
#pragma unroll
            for (int pt = 0; pt < 3; ++pt) pv[pt] = uu[pt][i] * w[pt][0] + uu[pt][i + 1] * w[pt][1] + uu[pt][i + 2] * w[pt][2] + bb[pt];
            zl[cl * 72 + tr * 8 + i] = (bf16_t)f2bf(pv[0] * pv[1]);
            P2[(size_t)(rowbase + t0 + tr * 8 + i) * 512 + c] = (bf16_t)f2bf(pv[2]); }
        __syncthreads();
        { const int cc = tid >> 3, part = tid & 7;
          *(u32x4*)(ZT + ((size_t)(ct * 64 + cc) * 8 + b) * L + t0 + part * 8) = *(const u32x4*)(zl + cc * 72 + part * 8); }
        __syncthreads();
    }
}
__device__ __forceinline__ void phase_hyena_fin(const Params& p, unsigned char* smem, int bid, int G, int tid) {
    const bf16_t* P2 = (const bf16_t*)(p.ws + WS_P2); bf16_t* MIX = (bf16_t*)(p.ws + WS_MIX);
    bf16_t* zl = (bf16_t*)smem;
    for (int u = bid; u < 2304; u += G) {
        int set, b, t0, ct, L, rowbase; hy_decode(u, set, b, t0, ct, L, rowbase);
        const bf16_t* ZT = set ? (const bf16_t*)(p.ws + WS_ZTC) : (const bf16_t*)(p.ws + WS_ZTL);
        { const int cc = tid >> 3, part = tid & 7;
          *(u32x4*)(zl + cc * 72 + part * 8) = *(const u32x4*)(ZT + ((size_t)(ct * 64 + cc) * 8 + b) * L + t0 + part * 8); }
        __syncthreads();
        const int cl = tid & 63, tr = tid >> 6, c = ct * 64 + cl;
#pragma unroll
        for (int i = 0; i < 8; ++i) { const int t = t0 + tr * 8 + i;
            const float y = bf2f(zl[cl * 72 + tr * 8 + i]), p2 = bf2f(P2[(size_t)(rowbase + t) * 512 + c]);
            MIX[(size_t)(rowbase + t) * 1024 + c] = (bf16_t)f2bf(y * p2); }
        __syncthreads();
    }
}

__device__ __forceinline__ void toeplitz_unit(unsigned char* smem, const float* kf_f, const float* kf_b, const bf16_t* zt, bf16_t* yt, float skip, int L, int tid, int wid, int lane) {
    const int CP = 2 * L + 8;
    bf16_t* Gc = (bf16_t*)smem;
    bf16_t* zs = (bf16_t*)(smem + (size_t)8 * CP * 2);
    float* red = (float*)(smem + (size_t)8 * CP * 2 + (size_t)8 * L * 2);
    float ss = 0.f;
    for (int i = tid; i < L; i += 512) { const float a = kf_f[i]; ss += a * a; if (i >= 1) { const float b = kf_b[i]; ss += b * b; } }
    ss = wave_sum(ss); if (lane == 0) red[wid] = ss;
    for (int i = tid; i < L; i += 512) ((u32x4*)zs)[i] = ((const u32x4*)zt)[i];
    __syncthreads();
    float tot = 0.f;
#pragma unroll
    for (int w = 0; w < 8; ++w) tot += red[w];
    const float nrm = rsqrtf(tot + 1e-6f);
    for (int pidx = tid; pidx < CP; pidx += 512) {
#pragma unroll
        for (int m = 0; m < 8; ++m) { const int x = pidx - m; float v = 0.f;
            if (x >= 1 && x <= L) v = kf_f[L - x]; else if (x > L && x <= 2 * L - 1) v = kf_b[x - L];
            Gc[m * CP + pidx] = (bf16_t)f2bf(v * nrm); }
    }
    __syncthreads();
    const int row = lane & 15, kg = lane >> 4;
    const int nJ = L / 32, tbw = (L / 16) / 8;
    const bf16_t* Gm = Gc + (row & 7) * CP;
    const bf16_t* zb = zs + (row & 7) * L + kg * 8;
    for (int g = 0; g < tbw; g += 2) {
        const int I0 = wid * tbw + g;
        f32x4 acc0 = {0.f, 0.f, 0.f, 0.f}, acc1 = {0.f, 0.f, 0.f, 0.f};
        const bf16_t* pa0 = Gm + (L - 16 * I0 + kg * 8 - (row & 8)); const bf16_t* pa1 = pa0 - 16;
        for (int J = 0; J < nJ; ++J) {
            const bf16x8 bz = *(const bf16x8*)(zb + 32 * J);
            const bf16x8 a0 = *(const bf16x8*)(pa0 + 32 * J);
            const bf16x8 a1 = *(const bf16x8*)(pa1 + 32 * J);
            acc0 = MFMA16(a0, bz, acc0); acc1 = MFMA16(a1, bz, acc1);
        }
        if (row < 8) {
#pragma unroll
            for (int q = 0; q < 2; ++q) { const f32x4 a = q ? acc1 : acc0; const int t = 16 * (I0 + q) + kg * 4;
                const bf16_t* zz = zs + row * L + t;
                u32x2 w; w.x = pk2(a[0] + bf2f(zz[0]) * skip, a[1] + bf2f(zz[1]) * skip); w.y = pk2(a[2] + bf2f(zz[2]) * skip, a[3] + bf2f(zz[3]) * skip);
                *(u32x2*)(yt + (size_t)row * L + t) = w; }
        }
    }
    __syncthreads();
}

constexpr int GL_LO = 0, GL_TOT = 8192, GL_BLAST = 10240, GL_QI = 10752, GL_KI = GL_QI + 18432, GL_KT = GL_KI + 18432, GL_VT = GL_KT + 18432, GL_ATT = GL_VT + 18432, GL_SSQ = GL_ATT + 18432;
template <bool DS>
__device__ __forceinline__ void gla_stage(unsigned char* smem, const bf16_t* PROJ, const float* GLO, const float* gate_up, const float* gate_b, int rowbase, int h, int tid) {
    float* lo_s = (float*)(smem + GL_LO); float* tot = (float*)(smem + GL_TOT); float* blast = (float*)(smem + GL_BLAST);
    bf16_t* qi = (bf16_t*)(smem + GL_QI); bf16_t* ki = (bf16_t*)(smem + GL_KI); bf16_t* kT = (bf16_t*)(smem + GL_KT); bf16_t* vT = (bf16_t*)(smem + GL_VT);
    ((f32x4*)lo_s)[tid] = ((const f32x4*)(GLO + (size_t)rowbase * 32))[tid];
    { const int dv = tid & 127, tg = tid >> 7;
#pragma unroll 4
      for (int i = 0; i < 16; ++i) { const int tok = tg * 16 + i; vT[dv * 72 + tok] = PROJ[(size_t)(rowbase + tok) * EINP + 2048 + h * 128 + dv]; } }
    __syncthreads();
    const int d = tid & 63, dir = (tid >> 6) & 1, qtr = tid >> 7;
    float gu[16];
#pragma unroll
    for (int r = 0; r < 16; ++r) gu[r] = gate_up[(dir * 16 + r) * 256 + h * 64 + d];
    const float gb = gate_b[dir * 256 + h * 64 + d];
    float lg[16];
#pragma unroll
    for (int i = 0; i < 16; ++i) { const int tok = qtr * 16 + i; float x = gb;
#pragma unroll
        for (int r = 0; r < 16; ++r) x += lo_s[tok * 32 + dir * 16 + r] * gu[r];
        lg[i] = (fminf(x, 0.f) - log1pf(__expf(-fabsf(x)))) * (1.f / 16.f); }
    float total;
    if (dir == 0) {
#pragma unroll
        for (int i = 1; i < 16; ++i) lg[i] += lg[i - 1];
        total = lg[15];
    } else {
#pragma unroll
        for (int i = 14; i >= 0; --i) lg[i] += lg[i + 1];
        total = lg[0];
    }
    tot[(dir * 4 + qtr) * 64 + d] = total;
    __syncthreads();
    float off = 0.f, all = 0.f;
#pragma unroll
    for (int q = 0; q < 4; ++q) { const float tq = tot[(dir * 4 + q) * 64 + d]; all += tq; if (dir == 0 ? (q < qtr) : (q > qtr)) off += tq; }
    if (qtr == 0) blast[dir * 64 + d] = all;
#pragma unroll
    for (int i = 0; i < 16; ++i) { const int tok = qtr * 16 + i; const float bb = off + lg[i];
        const float kin = bf2f(PROJ[(size_t)(rowbase + tok) * EINP + 1792 + h * 64 + d]) * __expf(-bb);
        if (DS) kT[(dir * 64 + d) * 72 + tok] = (bf16_t)f2bf(kin);
        else { ki[(dir * 64 + tok) * 72 + d] = (bf16_t)f2bf(kin);
            const float qin = bf2f(PROJ[(size_t)(rowbase + tok) * EINP + 1536 + h * 64 + d]) * 0.125f * __expf(bb);
            qi[(dir * 64 + tok) * 72 + d] = (bf16_t)f2bf(qin); } }
    __syncthreads();
}
__device__ __forceinline__ void gla_decode(int u, int& b, int& gc, int& h, int& rowbase) {
    h = u & 3; const int v = u >> 2; gc = v % 36; b = v / 36;
    rowbase = gc < 4 ? R_LAT + b * 256 + gc * 64 : b * 2048 + (gc - 4) * 64;
}
__device__ __forceinline__ void phase_gla_ds(const Params& p, int e, unsigned char* smem, int bid, int G, int tid, int wid, int lane) {
    const bf16_t* PROJ = (const bf16_t*)(p.ws + WS_PROJ); const float* GLO = (const float*)(p.ws + WS_GLO);
    float* DSb = (float*)(p.ws + WS_DS); float* DEC = (float*)(p.ws + WS_DEC);
    const float* gup = p.in[23] + (size_t)e * 2 * 16 * 256; const float* gbb = p.in[24] + (size_t)e * 2 * 256;
    const bf16_t* kT = (const bf16_t*)(smem + GL_KT); const bf16_t* vT = (const bf16_t*)(smem + GL_VT); const float* blast = (const float*)(smem + GL_BLAST);
    const int row = lane & 15, kg = lane >> 4;
    for (int u = bid; u < 1152; u += G) {
        int b, gc, h, rowbase; gla_decode(u, b, gc, h, rowbase);
        gla_stage<true>(smem, PROJ, GLO, gup, gbb, rowbase, h, tid);
        const int dir = wid >> 2, dkb = wid & 3;
        bf16x8 a[2];
#pragma unroll
        for (int ks = 0; ks < 2; ++ks) a[ks] = *(const bf16x8*)(kT + (dir * 64 + dkb * 16 + row) * 72 + ks * 32 + kg * 8);
        float eb[4];
#pragma unroll
        for (int i = 0; i < 4; ++i) eb[i] = __expf(blast[dir * 64 + dkb * 16 + kg * 4 + i]);
        const size_t base = (size_t)((b * 4 + h) * 2 + dir) * 36 + gc;
#pragma unroll
        for (int nb = 0; nb < 8; ++nb) {
            f32x4 acc = {0.f, 0.f, 0.f, 0.f};
#pragma unroll
            for (int ks = 0; ks < 2; ++ks) { const bf16x8 bv = *(const bf16x8*)(vT + (nb * 16 + row) * 72 + ks * 32 + kg * 8); acc = MFMA16(a[ks], bv, acc); }
            const f32x4 o = {acc[0] * eb[0], acc[1] * eb[1], acc[2] * eb[2], acc[3] * eb[3]};
            *(f32x4*)(DSb + base * 8192 + (size_t)(nb * 16 + row) * 64 + dkb * 16 + kg * 4) = o;
        }
        if (row == 0) *(f32x4*)(DEC + base * 64 + dkb * 16 + kg * 4) = (f32x4){eb[0], eb[1], eb[2], eb[3]};
        __syncthreads();
    }
}
__device__ __forceinline__ void phase_gla_scan(const Params& p, int bid, int G, int tid) {
    const float* DSb = (const float*)(p.ws + WS_DS); const float* DEC = (const float*)(p.ws + WS_DEC); bf16_t* SB = (bf16_t*)(p.ws + WS_SB);
    for (int gt = bid * 512 + tid; gt < 64 * 2048; gt += G * 512) {
        const int bhd = gt >> 11, eg = gt & 2047, dir = bhd & 1, dk4 = (eg & 15) * 4;
        f32x4 S = {0.f, 0.f, 0.f, 0.f};
#pragma unroll 4
        for (int step = 0; step < 36; ++step) {
            const int gc = dir == 0 ? step : (step < 4 ? 3 - step : 39 - step);
            const size_t cb = (size_t)bhd * 36 + gc;
            const f32x4 ds = *(const f32x4*)(DSb + cb * 8192 + (size_t)eg * 4);
            const f32x4 dc = *(const f32x4*)(DEC + cb * 64 + dk4);
            u32x2 w; w.x = pk2(S[0], S[1]); w.y = pk2(S[2], S[3]);
            *(u32x2*)(SB + cb * 8192 + (size_t)eg * 4) = w;
            S = dc * S + ds;
        }
    }
}
__device__ __forceinline__ void phase_gla_out(const Params& p, int e, unsigned char* smem, int bid, int G, int tid, int wid, int lane) {
    const bf16_t* PROJ = (const bf16_t*)(p.ws + WS_PROJ); const float* GLO = (const float*)(p.ws + WS_GLO);
    const bf16_t* SB = (const bf16_t*)(p.ws + WS_SB); bf16_t* MIX = (bf16_t*)(p.ws + WS_MIX);
    const float* gup = p.in[23] + (size_t)e * 2 * 16 * 256; const float* gbb = p.in[24] + (size_t)e * 2 * 256; const float* ng = p.in[25] + (size_t)e * 128;
    const bf16_t* qi = (const bf16_t*)(smem + GL_QI); const bf16_t* ki = (const bf16_t*)(smem + GL_KI); const bf16_t* vT = (const bf16_t*)(smem + GL_VT);
    bf16_t* att = (bf16_t*)(smem + GL_ATT); float* ssq = (float*)(smem + GL_SSQ);
    const int row = lane & 15, kg = lane >> 4;
    for (int u = bid; u < 1152; u += G) {
        int b, gc, h, rowbase; gla_decode(u, b, gc, h, rowbase);
        gla_stage<false>(smem, PROJ, GLO, gup, gbb, rowbase, h, tid);
        {   const int dir = wid >> 2, rb = wid & 3;
            bf16x8 aq[2];
#pragma unroll
            for (int ks = 0; ks < 2; ++ks) aq[ks] = *(const bf16x8*)(qi + (dir * 64 + rb * 16 + row) * 72 + ks * 32 + kg * 8);
#pragma unroll
            for (int cb = 0; cb < 4; ++cb) {
                f32x4 acc = {0.f, 0.f, 0.f, 0.f};
                const bool live = dir == 0 ? (cb <= rb) : (cb >= rb);
                if (live) {
#pragma unroll
                    for (int ks = 0; ks < 2; ++ks) { const bf16x8 bk = *(const bf16x8*)(ki + (dir * 64 + cb * 16 + row) * 72 + ks * 32 + kg * 8); acc = MFMA16(aq[ks], bk, acc); }
                }
#pragma unroll
                for (int i = 0; i < 4; ++i) { const int tq = rb * 16 + kg * 4 + i, tk = cb * 16 + row; const bool keep = dir == 0 ? (tk <= tq) : (tk >= tq);
                    att[(dir * 64 + tq) * 72 + tk] = (bf16_t)f2bf(keep ? acc[i] : 0.f); }
            }
        }
        __syncthreads();
        {   const int dvb = wid;
            bf16x8 bv[2], bs[2][2];
#pragma unroll
            for (int ks = 0; ks < 2; ++ks) bv[ks] = *(const bf16x8*)(vT + (dvb * 16 + row) * 72 + ks * 32 + kg * 8);
#pragma unroll
            for (int dir = 0; dir < 2; ++dir)
#pragma unroll
                for (int ks = 0; ks < 2; ++ks) bs[dir][ks] = *(const bf16x8*)(SB + ((size_t)((b * 4 + h) * 2 + dir) * 36 + gc) * 8192 + (size_t)(dvb * 16 + row) * 64 + ks * 32 + kg * 8);
            f32x4 o[4];
#pragma unroll
            for (int rb = 0; rb < 4; ++rb) { f32x4 acc = {0.f, 0.f, 0.f, 0.f};
#pragma unroll
                for (int dir = 0; dir < 2; ++dir)
#pragma unroll
                    for (int ks = 0; ks < 2; ++ks) {
                        const bf16x8 a1 = *(const bf16x8*)(att + (dir * 64 + rb * 16 + row) * 72 + ks * 32 + kg * 8); acc = MFMA16(a1, bv[ks], acc);
                        const bf16x8 a2 = *(const bf16x8*)(qi + (dir * 64 + rb * 16 + row) * 72 + ks * 32 + kg * 8); acc = MFMA16(a2, bs[dir][ks], acc); }
                o[rb] = acc; }
#pragma unroll
            for (int rb = 0; rb < 4; ++rb)
#pragma unroll
                for (int i = 0; i < 4; ++i) { float s = o[rb][i] * o[rb][i];
                    s += __shfl_xor(s, 1); s += __shfl_xor(s, 2); s += __shfl_xor(s, 4); s += __shfl_xor(s, 8);
                    if (row == 0) ssq[wid * 64 + rb * 16 + kg * 4 + i] = s; }
            __syncthreads();
            const int dv = dvb * 16 + row; const float gn = ng[dv];
#pragma unroll
            for (int rb = 0; rb < 4; ++rb)
#pragma unroll
                for (int i = 0; i < 4; ++i) { const int tok = rb * 16 + kg * 4 + i; float t = 0.f;
#pragma unroll
                    for (int w = 0; w < 8; ++w) t += ssq[w * 64 + tok];
                    const float rstd = rsqrtf(t * (1.f / 128.f) + RMS_EPS);
                    const float gval = bf2f(PROJ[(size_t)(rowbase + tok) * EINP + 2560 + h * 128 + dv]);
                    MIX[(size_t)(rowbase + tok) * 1024 + 512 + h * 128 + dv] = (bf16_t)f2bf(o[rb][i] * rstd * gn * silu_f(gval)); }
        }
        __syncthreads();
    }
}
#ifndef MK_MULTI
#define MK_MULTI 0
#endif
#ifndef REP_G1
#define REP_G1 1
#endif
#ifndef REP_PROJ
#define REP_PROJ 1
#endif
#ifndef REP_RESID
#define REP_RESID 1
#endif
#ifndef REP_LN
#define REP_LN 1
#endif
#ifndef REP_ATTN
#define REP_ATTN 1
#endif
#ifndef REP_E2
#define REP_E2 1
#endif
#ifndef REP_E3
#define REP_E3 1
#endif
#ifndef REP_E4
#define REP_E4 1
#endif
#ifndef REP_P01
#define REP_P01 1
#endif
constexpr size_t WS_SCR_H = WS_END;
constexpr size_t WS_SCR_A = WS_SCR_H + (size_t)R_ALL * 1024 * 4;
__global__ void __launch_bounds__(512) mega_fwd(Params p) {
    extern __shared__ __attribute__((aligned(16))) unsigned char smem[];
    cg::grid_group grid = cg::this_grid();
    const int bid = blockIdx.x, G = gridDim.x;
    PG8_LAS unsigned char* lds3 = (PG8_LAS unsigned char*)smem;
    volatile LAS unsigned* bst = (volatile LAS unsigned*)(lds3 + LDS_BYTES - 16);
    if (threadIdx.x < 4) bst[threadIdx.x] = 0u;
    __syncthreads();
    XcdBarrier bar = xcd_barrier_post((unsigned*)(p.ws + WS_CTL), bst);
    int ph = 0;
#define PH_BEGIN if (ph >= p.lo && ph < p.hi) { const int tid = otid(); const int wid = __builtin_amdgcn_readfirstlane(tid >> 6), lane = tid & 63; unsigned char* ws = p.ws; asm volatile("" : "+s"(ws)); (void)wid; (void)lane; (void)ws;
#define PH_END   if (ph + 1 < p.hi) { if (ph == p.lo) grid.sync(); else xcd_barrier(bar); } } ++ph;

    PH_BEGIN for (int rep = 0; rep < REP_P01; ++rep) { phase_mod_filters(p, smem, bid, G, tid, wid, lane); __syncthreads(); } PH_END
    PH_BEGIN for (int rep = 0; rep < REP_P01; ++rep) { phase_convert_init(p, smem, bid, G, tid, wid, lane); __syncthreads(); } PH_END

    for (int sl = 0; sl < 12; ++sl) {
        const int l = sl / 3, kind = sl % 3;
        const bool lastl = (l == 3), even = ((l & 1) == 0);
        const int eo = l >> 1;
        const int Mtail = (lastl && kind >= 1) ? R_LAT : R_ALL;
        if (kind != 1) {
            const int s = kind == 0 ? 0 : 1;
            PH_BEGIN
                pg8::Gemm g{(const pg8::bf16_t*)(ws + WS_A), (const pg8::bf16_t*)(ws + WS_WT1) + (size_t)(l * 2 + s) * 5632 * 1024, Mtail, 5632, 1024};
                pg8::StaticOrder S; S.init(g.M, g.N, G, bid);
                pg8::EpiSwiglu E{(pg8::bf16_t*)(ws + WS_ACT)};
                for (int rep = 0; rep < REP_G1; ++rep)
                    pg8::gemm_phase<pg8::EpiSwiglu, pg8::StaticOrder, true, true>(lds3, g, S, E);
            PH_END
        } else {
            PH_BEGIN
                pg8::Gemm g{(const pg8::bf16_t*)(ws + WS_A), even ? (const pg8::bf16_t*)(ws + WS_WEI) + (size_t)eo * EINP * 1024 : (const pg8::bf16_t*)(ws + WS_WAI) + (size_t)eo * OIN * 1024,
                            R_ALL, even ? EINP : OIN, 1024};
                pg8::StaticOrder S; S.init(g.M, g.N, G, bid);
                pg8::EpiProj E{(pg8::bf16_t*)(ws + WS_PROJ), even ? EINP : OIN, even ? 3072 : (1 << 30), (float*)(ws + WS_GLO)};
                for (int rep = 0; rep < REP_PROJ; ++rep)
                    pg8::gemm_phase<pg8::EpiProj, pg8::StaticOrder, true, true>(lds3, g, S, E);
            PH_END
            if (even) {
                PH_BEGIN for (int rep = 0; rep < REP_E2; ++rep) { phase_shortconv(p, eo, smem, bid, G, tid); phase_gla_ds(p, eo, smem, bid, G, tid, wid, lane); } PH_END
                PH_BEGIN
                    for (int rep = 0; rep < REP_E3; ++rep) {
                        phase_gla_scan(p, bid, G, tid);
                        for (int u = bid; u < 1024; u += G) {
                            const int set = u >= 512, c = u & 511, L = set ? 256 : 2048;
                            const float* kf = (set ? (const float*)(ws + WS_KFC) : (const float*)(ws + WS_KFL)) + (size_t)eo * 2 * 512 * L;
                            bf16_t* zt = (set ? (bf16_t*)(ws + WS_ZTC) : (bf16_t*)(ws + WS_ZTL)) + (size_t)c * 8 * L;
                            bf16_t* yt = rep + 1 < REP_E3 ? (bf16_t*)(ws + WS_SCR_H) + (size_t)u * 8 * 2048 : zt;
                            toeplitz_unit(smem, kf + (size_t)c * L, kf + (size_t)(512 + c) * L, zt, yt, p.in[22][eo * 512 + c], L, tid, wid, lane);
                        }
                    }
                PH_END
                PH_BEGIN for (int rep = 0; rep < REP_E4; ++rep) { phase_gla_out(p, eo, smem, bid, G, tid, wid, lane); phase_hyena_fin(p, smem, bid, G, tid); } PH_END
            } else {
                PH_BEGIN for (int rep = 0; rep < REP_ATTN; ++rep) phase_normrope(p, eo, bid, G, wid, lane); PH_END
                PH_BEGIN for (int rep = 0; rep < REP_ATTN; ++rep) phase_attn(p, !lastl, smem, bid, G); PH_END
            }
        }
        PH_BEGIN
            const pg8::bf16_t* Aop; const pg8::bf16_t* Bop; int K; float scale;
            if (kind != 1) { const int s = kind == 0 ? 0 : 1; Aop = (const pg8::bf16_t*)(ws + WS_ACT); Bop = (const pg8::bf16_t*)(ws + WS_WT2) + (size_t)(l * 2 + s) * 1024 * 2816; K = 2816; scale = 0.5f; }
            else { Aop = (const pg8::bf16_t*)(ws + WS_MIX); Bop = (even ? (const pg8::bf16_t*)(ws + WS_WEO) : (const pg8::bf16_t*)(ws + WS_WAO)) + (size_t)eo * 1024 * 1024; K = 1024; scale = 1.f; }
            pg8::Gemm g{Aop, Bop, Mtail, 1024, K};
            pg8::StaticOrder S; S.init(g.M, g.N, G, bid);
            for (int rep = 0; rep < REP_RESID; ++rep) {
                pg8::EpiResid E{(float*)(ws + (rep + 1 < REP_RESID ? WS_SCR_H : WS_H)), (const float*)(ws + WS_MODV) + (size_t)l * 9 * NMODC + (size_t)(3 * kind + 2) * 1024, scale};
                pg8::gemm_phase<pg8::EpiResid, pg8::StaticOrder, true, true>(lds3, g, S, E);
            }
        PH_END
        PH_BEGIN
            for (int rep = 0; rep < REP_LN; ++rep) {
                const bool scr = rep + 1 < REP_LN;
                phase_ln(p, (float*)(ws + (scr ? WS_SCR_H : WS_H)), (bf16_t*)(ws + (scr ? WS_SCR_A : WS_A)), scr ? (float*)(ws + WS_SCR_H) : p.out, sl, Mtail, bid, G, wid, lane);
            }
        PH_END
    }
#undef PH_BEGIN
#undef PH_END
}

extern "C" void kernel_launch(void* const* d_in, const int* in_sizes, int n_in, void* d_out, int out_size, void* d_ws, size_t ws_size, hipStream_t stream) {
    static int grid = 0;
    if (grid == 0) {
        if (n_in != 30 || out_size != R_LAT * DM || ws_size < WS_SCR_A + (size_t)R_ALL * 1024 * 2) { fprintf(stderr, "kernel_launch: unexpected shapes: n_in %d out %d ws %zu (need %zu)\n", n_in, out_size, ws_size, (size_t)WS_END); grid = -1; return; }
        int dev = 0, cus = 0, per_cu = 0;
        (void)hipGetDevice(&dev); (void)hipDeviceGetAttribute(&cus, hipDeviceAttributeMultiprocessorCount, dev);
        if (hipFuncSetAttribute((const void*)mega_fwd, hipFuncAttributeMaxDynamicSharedMemorySize, LDS_BYTES) != hipSuccess) { fprintf(stderr, "kernel_launch: hipFuncSetAttribute failed\n"); grid = -1; return; }
        if (hipOccupancyMaxActiveBlocksPerMultiprocessor(&per_cu, (const void*)mega_fwd, 512, LDS_BYTES) != hipSuccess || per_cu < 1) { fprintf(stderr, "kernel_launch: occupancy query gives %d\n", per_cu); per_cu = 1; }
        (void)hipGetLastError();
        grid = cus * 1;
        if (grid <= 0) grid = 256;
    }
    if (grid < 0) return;
    Params p{};
    for (int i = 0; i < 30; ++i) p.in[i] = (const float*)d_in[i];
    p.out = (float*)d_out; p.ws = (unsigned char*)d_ws;
#if MK_MULTI
    for (int ph = 0; ph < NPHASES; ++ph) { p.lo = ph; p.hi = ph + 1; hipLaunchKernelGGL(mega_fwd, dim3(grid), dim3(512), LDS_BYTES, stream, p); }
#else
    p.lo = 0; p.hi = NPHASES;
    if (hipMemsetAsync((char*)d_ws + WS_CTL, 0, 16384, stream) != hipSuccess) { fprintf(stderr, "kernel_launch: memset failed\n"); return; }
    void* args[] = {&p};
    hipError_t e = hipLaunchCooperativeKernel((const void*)mega_fwd, dim3(grid), dim3(512), args, LDS_BYTES, stream);
    if (e != hipSuccess) fprintf(stderr, "kernel_launch: cooperative launch failed: %s (grid %d)\n", hipGetErrorString(e), grid);
#endif
}
```
